# Optimizing an MI355X kernel written in HIP

```python
import jax
import jax.numpy as jnp
from jax import lax
import numpy as np

D_MODEL = 2048
BATCH = 4
SEQ = 2048
DEPTH = 2

MIX_WIDTH = D_MODEL
RWKV_WIDTH = MIX_WIDTH // 2
RWKV_HEAD_DIM = 64
RWKV_HEADS = RWKV_WIDTH // RWKV_HEAD_DIM
DECAY_LORA = 64
A_LORA = 64
GATE_LORA = 160
VRES_LORA = 32
MOBA_WIDTH = MIX_WIDTH - RWKV_WIDTH
MOBA_HEAD_DIM = 128
MOBA_HEADS = MOBA_WIDTH // MOBA_HEAD_DIM
MOBA_BLOCK = 256
MOBA_TOPK = 3
MOBA_Q_CHUNK = 16
D_FF = 5632
N_EXPERTS = 8
TOP_K = 2
D_FF_EXPERT = 5632
RMS_EPS = 1e-6
GN_EPS = 64e-5

kernel_name = "hybrid_rwkv7_moba_moe_adaln"


def rwkv_cols(value_residual):
    return 3 * RWKV_WIDTH + DECAY_LORA + A_LORA + GATE_LORA + (VRES_LORA if value_residual else 0)


def rms_norm(x, gain):
    xf = x.astype(jnp.float32)
    y = xf * lax.rsqrt(jnp.mean(xf * xf, axis=-1, keepdims=True) + RMS_EPS)
    return (y * gain.astype(jnp.float32)).astype(x.dtype)


def modulate(h, shift, scale):
    return h * (1 + scale[:, None, :]) + shift[:, None, :]


def token_shift(p, mu):
    prev = jnp.concatenate([jnp.zeros_like(p[:, :1]), p[:, :-1]], axis=1)
    return p + (prev - p) * mu


def rwkv7_recurrence(r, decay, k, v, a, b):
    B, T, H, N = r.shape

    def step(S, inp):
        r_t, w_t, k_t, v_t, a_t, b_t = inp
        sa = jnp.einsum('bhij,bhj->bhi', S, a_t)
        S = S * w_t[:, :, None, :] + sa[..., None] * b_t[:, :, None, :] + v_t[..., None] * k_t[:, :, None, :]
        return S, jnp.einsum('bhij,bhj->bhi', S, r_t)

    S0 = jnp.zeros((B, H, N, N), jnp.float32)
    xs = tuple(jnp.moveaxis(t.astype(jnp.float32), 1, 0) for t in (r, decay, k, v, a, b))
    _, ys = lax.scan(step, S0, xs)
    return jnp.moveaxis(ys, 0, 1)


def rwkv7_mixer(p, v_first, shift_mu, w0, w2, a0, a2, g2, v0, v2, k_k, k_a, r_k, ln_w, ln_b):
    B, T, _ = p.shape
    C, H, N = RWKV_WIDTH, RWKV_HEADS, RWKV_HEAD_DIM
    z = token_shift(p, shift_mu)
    sizes = [C, C, C, DECAY_LORA, A_LORA, GATE_LORA] + ([VRES_LORA] if v0 is not None else [])
    parts = jnp.split(z, np.cumsum(sizes)[:-1].tolist(), axis=-1)
    r, k, v, zw, za, zg = parts[:6]
    w = -jax.nn.softplus(-(w0 + jnp.tanh(zw) @ w2)) - 0.5
    decay = jnp.exp(-jnp.exp(w.astype(jnp.float32)))
    a = jax.nn.sigmoid(a0 + za @ a2)
    g = jax.nn.sigmoid(zg) @ g2
    if v0 is None:
        v_first = v
    else:
        v = v + (v_first - v) * jax.nn.sigmoid(v0 + parts[6] @ v2)
    heads = lambda t: t.reshape(B, T, H, N)
    kk = heads(k * k_k).astype(jnp.float32)
    kk = kk * lax.rsqrt(jnp.maximum(jnp.sum(kk * kk, axis=-1, keepdims=True), 1e-24))
    k = k * (1 + (a - 1) * k_a)
    a_h = heads(a).astype(jnp.float32)
    y = rwkv7_recurrence(heads(r), heads(decay), heads(k), heads(v), -kk, kk * a_h)
    mean = jnp.mean(y, axis=-1, keepdims=True)
    var = jnp.mean(jnp.square(y - mean), axis=-1, keepdims=True)
    y = ((y - mean) * lax.rsqrt(var + GN_EPS)).reshape(B, T, C) * ln_w + ln_b
    bonus = jnp.sum(heads(r) * heads(k) * r_k, axis=-1, keepdims=True) * heads(v)
    out = (y + bonus.reshape(B, T, C).astype(jnp.float32)) * g
    return out.astype(p.dtype), v_first


def moba_attention(q, k, v, gain):
    B, T, _ = q.shape
    H, Dh, BS, QC = MOBA_HEADS, MOBA_HEAD_DIM, MOBA_BLOCK, MOBA_Q_CHUNK
    to_heads = lambda t: t.reshape(B, T, H, Dh).transpose(0, 2, 1, 3)
    q, k, v = to_heads(q), to_heads(k), to_heads(v)
    n_blocks = -(-T // BS)
    pad = n_blocks * BS - T
    kp = jnp.pad(k, ((0, 0), (0, 0), (0, pad), (0, 0)))
    vp = jnp.pad(v, ((0, 0), (0, 0), (0, pad), (0, 0)))
    k_blocks = kp.reshape(B, H, n_blocks, BS, Dh)
    v_blocks = vp.reshape(B, H, n_blocks, BS, Dh)
    k_mean = jnp.mean(k_blocks.astype(jnp.float32), axis=3)
    topk = min(MOBA_TOPK, n_blocks)
    slopes = jnp.exp2(-8.0 * jnp.arange(1, H + 1, dtype=jnp.float32) / H)
    scale = Dh ** -0.5
    b_idx = jnp.arange(B)[:, None, None, None]
    h_idx = jnp.arange(H)[None, :, None, None]
    block_ids = jnp.arange(n_blocks)
    key_offsets = jnp.arange(BS)

    def chunk(ci):
        start = ci * QC
        own = start // BS
        qc = lax.dynamic_slice_in_dim(q, start, QC, axis=2)
        t_pos = (start + jnp.arange(QC))[:, None, None]
        gate = jnp.einsum('bhqd,bhnd->bhqn', qc.astype(jnp.float32), k_mean)
        gate = jnp.where(block_ids < own, gate, -jnp.inf)
        _, sel = lax.top_k(gate, topk)
        valid = (jnp.arange(topk) < own)[:, None]
        k_sel = k_blocks[b_idx, h_idx, sel]
        v_sel = v_blocks[b_idx, h_idx, sel]
        dist_sel = (t_pos - (sel[..., None] * BS + key_offsets)).astype(jnp.float32)
        s_sel = (jnp.einsum('bhqd,bhqksd->bhqks', qc, k_sel).astype(jnp.float32) * scale
                 - slopes[:, None, None, None] * dist_sel)
        s_sel = jnp.where(valid, s_sel, -jnp.inf).reshape(B, H, QC, topk * BS)
        k_own = lax.dynamic_slice_in_dim(kp, own * BS, BS, axis=2)
        v_own = lax.dynamic_slice_in_dim(vp, own * BS, BS, axis=2)
        dist_own = (t_pos[..., 0] - (own * BS + key_offsets)).astype(jnp.float32)
        s_own = (jnp.einsum('bhqd,bhsd->bhqs', qc, k_own).astype(jnp.float32) * scale
                 - slopes[:, None, None] * dist_own)
        s_own = jnp.where(dist_own >= 0, s_own, -jnp.inf)
        probs = jax.nn.softmax(jnp.concatenate([s_sel, s_own], axis=-1), axis=-1).astype(v.dtype)
        p_sel = probs[..., :topk * BS].reshape(B, H, QC, topk, BS)
        p_own = probs[..., topk * BS:]
        return (jnp.einsum('bhqks,bhqksd->bhqd', p_sel, v_sel)
                + jnp.einsum('bhqs,bhsd->bhqd', p_own, v_own))

    out = lax.map(chunk, jnp.arange(T // QC))
    out = out.transpose(1, 0, 3, 2, 4).reshape(B, T, H, Dh)
    out = rms_norm(out, gain.reshape(H, Dh))
    return out.reshape(B, T, MOBA_WIDTH)


def mixer_sublayer(h, v_first, p):
    n_r = p["shift_mu"].shape[0]
    proj = h @ p["w_in"]
    y_r, v_first = rwkv7_mixer(proj[..., :n_r], v_first, p["shift_mu"], p["w0"], p["w2"], p["a0"],
                               p["a2"], p["g2"], p.get("v0"), p.get("v2"), p["k_k"], p["k_a"],
                               p["r_k"], p["ln_w"], p["ln_b"])
    pm = proj[..., n_r:]
    y_m = moba_attention(pm[..., :MOBA_WIDTH], pm[..., MOBA_WIDTH:2 * MOBA_WIDTH],
                         pm[..., 2 * MOBA_WIDTH:], p["moba_gain"])
    return jnp.concatenate([y_r, y_m], axis=-1) @ p["w_out"], v_first


def swiglu(h, w_gate, w_up, w_down):
    return (jax.nn.silu(h @ w_gate) * (h @ w_up)) @ w_down


def moe_swiglu(h, router, w_gate, w_up, w_down):
    logits = (h @ router).astype(jnp.float32)
    top_val, top_idx = lax.top_k(logits, TOP_K)
    top_w = jax.nn.softmax(top_val, axis=-1)
    gates = jnp.sum(jax.nn.one_hot(top_idx, N_EXPERTS, dtype=jnp.float32) * top_w[..., None], axis=-2)
    out = jnp.zeros_like(h)
    for e in range(N_EXPERTS):
        out = out + gates[..., e:e + 1].astype(h.dtype) * swiglu(h, w_gate[e], w_up[e], w_down[e])
    return out


def setup_inputs(seed: int = 0) -> dict:
    key = jax.random.key(seed)
    keys = iter(jax.random.split(key, 96))
    normal = lambda shape, s: s * jax.random.normal(next(keys), shape, jnp.float32)
    uniform = lambda shape, lo, hi: jax.random.uniform(next(keys), shape, jnp.float32, lo, hi)
    D, C, H, N = D_MODEL, RWKV_WIDTH, RWKV_HEADS, RWKV_HEAD_DIM
    inp = {}
    inp["x"] = normal((BATCH, SEQ, D), 1.0)
    inp["c"] = normal((BATCH, D), 1.0)
    for i in range(DEPTH):
        pre = "l%d_" % i
        vres = i > 0
        inp[pre + "mod_w"] = normal((D, 6 * D), 0.5 * D ** -0.5)
        inp[pre + "mod_b"] = normal((6 * D,), 0.02)
        inp[pre + "norm_mix"] = 1.0 + normal((D,), 0.02)
        inp[pre + "w_in"] = normal((D, rwkv_cols(vres) + 3 * MOBA_WIDTH), D ** -0.5)
        inp[pre + "shift_mu"] = uniform((rwkv_cols(vres),), 0.0, 1.0)
        inp[pre + "w0"] = uniform((C,), -6.5, -1.5)
        inp[pre + "w2"] = normal((DECAY_LORA, C), 0.5 * DECAY_LORA ** -0.5)
        inp[pre + "a0"] = normal((C,), 0.1)
        inp[pre + "a2"] = normal((A_LORA, C), 0.5 * A_LORA ** -0.5)
        inp[pre + "g2"] = normal((GATE_LORA, C), GATE_LORA ** -0.5)
        if vres:
            inp[pre + "v0"] = normal((C,), 0.1)
            inp[pre + "v2"] = normal((VRES_LORA, C), 0.5 * VRES_LORA ** -0.5)
        inp[pre + "k_k"] = 0.85 + normal((C,), 0.02)
        inp[pre + "k_a"] = 1.0 + normal((C,), 0.02)
        inp[pre + "r_k"] = normal((H, N), 0.1)
        inp[pre + "ln_w"] = 1.0 + normal((C,), 0.02)
        inp[pre + "ln_b"] = normal((C,), 0.02)
        inp[pre + "moba_gain"] = 1.0 + normal((MOBA_WIDTH,), 0.02)
        inp[pre + "w_out"] = normal((MIX_WIDTH, D), MIX_WIDTH ** -0.5)
        inp[pre + "norm_ffn"] = 1.0 + normal((D,), 0.02)
        if i % 2 == 0:
            inp[pre + "ffn_gate"] = normal((D, D_FF), D ** -0.5)
            inp[pre + "ffn_up"] = normal((D, D_FF), D ** -0.5)
            inp[pre + "ffn_down"] = normal((D_FF, D), D_FF ** -0.5)
        else:
            inp[pre + "router"] = normal((D, N_EXPERTS), D ** -0.5)
            inp[pre + "exp_gate"] = normal((N_EXPERTS, D, D_FF_EXPERT), D ** -0.5)
            inp[pre + "exp_up"] = normal((N_EXPERTS, D, D_FF_EXPERT), D ** -0.5)
            inp[pre + "exp_down"] = normal((N_EXPERTS, D_FF_EXPERT, D), D_FF_EXPERT ** -0.5)
    inp["norm_out"] = 1.0 + normal((D,), 0.02)
    return inp


def reference(x, c,
              l0_mod_w, l0_mod_b, l0_norm_mix, l0_w_in, l0_shift_mu, l0_w0, l0_w2, l0_a0, l0_a2, l0_g2,
              l0_k_k, l0_k_a, l0_r_k, l0_ln_w, l0_ln_b, l0_moba_gain, l0_w_out, l0_norm_ffn,
              l0_ffn_gate, l0_ffn_up, l0_ffn_down,
              l1_mod_w, l1_mod_b, l1_norm_mix, l1_w_in, l1_shift_mu, l1_w0, l1_w2, l1_a0, l1_a2, l1_g2,
              l1_v0, l1_v2, l1_k_k, l1_k_a, l1_r_k, l1_ln_w, l1_ln_b, l1_moba_gain, l1_w_out, l1_norm_ffn,
              l1_router, l1_exp_gate, l1_exp_up, l1_exp_down,
              norm_out):
    layers = (
        dict(mod_w=l0_mod_w, mod_b=l0_mod_b, norm_mix=l0_norm_mix, w_in=l0_w_in, shift_mu=l0_shift_mu,
             w0=l0_w0, w2=l0_w2, a0=l0_a0, a2=l0_a2, g2=l0_g2, k_k=l0_k_k, k_a=l0_k_a, r_k=l0_r_k,
             ln_w=l0_ln_w, ln_b=l0_ln_b, moba_gain=l0_moba_gain, w_out=l0_w_out, norm_ffn=l0_norm_ffn,
             ffn_gate=l0_ffn_gate, ffn_up=l0_ffn_up, ffn_down=l0_ffn_down),
        dict(mod_w=l1_mod_w, mod_b=l1_mod_b, norm_mix=l1_norm_mix, w_in=l1_w_in, shift_mu=l1_shift_mu,
             w0=l1_w0, w2=l1_w2, a0=l1_a0, a2=l1_a2, g2=l1_g2, v0=l1_v0, v2=l1_v2, k_k=l1_k_k,
             k_a=l1_k_a, r_k=l1_r_k, ln_w=l1_ln_w, ln_b=l1_ln_b, moba_gain=l1_moba_gain, w_out=l1_w_out,
             norm_ffn=l1_norm_ffn, router=l1_router, exp_gate=l1_exp_gate, exp_up=l1_exp_up,
             exp_down=l1_exp_down),
    )
    c_act = jax.nn.silu(c)
    v_first = None
    for i in range(DEPTH):
        p = layers[i]
        mod = c_act @ p["mod_w"] + p["mod_b"]
        shift_m, scale_m, gate_m, shift_f, scale_f, gate_f = jnp.split(mod, 6, axis=-1)
        h = modulate(rms_norm(x, p["norm_mix"]), shift_m, scale_m)
        mix, v_first = mixer_sublayer(h, v_first, p)
        x = x + gate_m[:, None, :] * mix
        h = modulate(rms_norm(x, p["norm_ffn"]), shift_f, scale_f)
        if i % 2 == 0:
            f = swiglu(h, p["ffn_gate"], p["ffn_up"], p["ffn_down"])
        else:
            f = moe_swiglu(h, p["router"], p["exp_gate"], p["exp_up"], p["exp_down"])
        x = x + gate_f[:, None, :] * f
    return rms_norm(x, norm_out)
```

```cpp
#include <hip/hip_runtime.h>
#include <stdint.h>
#include <string.h>
#include <stdio.h>
namespace pg8 {
#define PG8_LAS __attribute__((address_space(3)))
typedef unsigned short bf16_t;
typedef short bf16x8 __attribute__((ext_vector_type(8)));
typedef float f32x4 __attribute__((ext_vector_type(4)));
typedef unsigned u32x4 __attribute__((ext_vector_type(4)));
constexpr int BM = 256, BK = 64, HALF = 128, HTB = HALF * BK * 2  , STAGE_BYTES = 8 * HTB, NXCD = 8, WGM = 8;

__host__ __device__ __forceinline__ int lds_byte(int r, int c) { const int st = (r >> 4) * 2 + (c >> 5), rr = r & 15, cc = c & 31, ob = rr * 64 + cc * 2; return st * 1024 + (ob ^ (((ob >> 9) & 1) << 5)); }
__host__ __device__ __forceinline__ void stage_rc(int b, int& R, int& C) { const int st = b / 1024, sb = b % 1024, swz = sb ^ (((sb >> 9) & 1) << 5); R = (st >> 1) * 16 + swz / 64; C = (st & 1) * 32 + (swz % 64) / 2; }
__host__ __device__ __forceinline__ int perm32(int rho) { const int n = rho >> 4, i = rho & 15; return 8 * (i >> 2) + 4 * n + (i & 3); }

struct Unit { int pm, pn; };
struct Gemm { const bf16_t* A; const bf16_t* Bt; int M, N, K; };

struct StaticOrder {
    int nM, nN, nwg, G, c;
    __host__ __device__ void init(int M, int N, int G_, int c_) { nM = M / BM; nN = N / BM; nwg = nM * nN; G = G_; c = c_; }
    __host__ __device__ bool next(int i, Unit& u) const {
        const long L = (long)i * G + c; if (L >= nwg) return false;
        int wgid = (int)L; { const int q = nwg / NXCD, r = nwg % NXCD, xcd = wgid % NXCD, off = wgid / NXCD; wgid = (xcd < r ? xcd * (q + 1) : r * (q + 1) + (xcd - r) * q) + off; }
        const int nig = WGM * nN, gid = wgid / nig, fm = gid * WGM, gsz = (nM - fm) < WGM ? (nM - fm) : WGM;
        u.pm = fm + ((wgid % nig) % gsz); u.pn = (wgid % nig) / gsz; return true;
    }
    __device__ __forceinline__ void a_ready(const Unit&) const {}
    __device__ __forceinline__ void done(const Unit&) const {}
};

typedef float f32x2cv_ __attribute__((ext_vector_type(2))); typedef __bf16 bf16x2cv_ __attribute__((ext_vector_type(2)));
__device__ __forceinline__ unsigned cvt_pk_bf16(float lo, float hi) { const f32x2cv_ v = {lo, hi}; const bf16x2cv_ b = __builtin_convertvector(v, bf16x2cv_); return __builtin_bit_cast(unsigned, b); }

__device__ __forceinline__ float silu_f(float x) { return x * __builtin_amdgcn_rcpf(1.0f + __expf(-x)); }
struct EpiStoreBf16 {
    static constexpr bool PERM = true, AFTER_DRAIN = false;
    bf16_t* O; int ldc;
    __device__ __forceinline__ void operator()(const f32x4 (&acc)[2][2][4][2], const Unit& u, int wr, int wc, int fr, int fq) const {
        const int row0 = u.pm * BM + wr * 64 + fr, col0 = u.pn * BM + wc * 32 + 8 * fq;
#pragma unroll
        for (int ai = 0; ai < 2; ++ai)
#pragma unroll
            for (int m = 0; m < 4; ++m) { bf16_t* rowp = O + (size_t)(row0 + ai * HALF + m * 16) * ldc + col0;
#pragma unroll
                for (int bj = 0; bj < 2; ++bj) { const f32x4 v0 = acc[ai][bj][m][0], v1 = acc[ai][bj][m][1];
                    u32x4 w; w.x = cvt_pk_bf16(v0[0], v0[1]); w.y = cvt_pk_bf16(v0[2], v0[3]); w.z = cvt_pk_bf16(v1[0], v1[1]); w.w = cvt_pk_bf16(v1[2], v1[3]);
                    *(u32x4*)(rowp + bj * HALF) = w; } }
    }
};
struct EpiResid {
    static constexpr bool PERM = false, AFTER_DRAIN = false;
    float* C; const float* R; const float* gate; int ldc, gstride, tiles_per_batch;
    __device__ __forceinline__ void operator()(const f32x4 (&acc)[2][2][4][2], const Unit& u, int wr, int wc, int fr, int fq) const {
        const int row0 = u.pm * BM + wr * 64 + fr, col0 = u.pn * BM + wc * 32 + 4 * fq;
        const float* gp = gate + (size_t)(u.pm / tiles_per_batch) * gstride + col0;
        f32x4 gv[2][2];
#pragma unroll
        for (int bj = 0; bj < 2; ++bj)
#pragma unroll
            for (int n = 0; n < 2; ++n) gv[bj][n] = *(const f32x4*)(gp + bj * HALF + n * 16);
#pragma unroll
        for (int ai = 0; ai < 2; ++ai)
#pragma unroll
            for (int m = 0; m < 4; ++m) { const size_t off = (size_t)(row0 + ai * HALF + m * 16) * ldc + col0;
#pragma unroll
                for (int bj = 0; bj < 2; ++bj)
#pragma unroll
                    for (int n = 0; n < 2; ++n) { const f32x4 r = *(const f32x4*)(R + off + bj * HALF + n * 16); *(f32x4*)(C + off + bj * HALF + n * 16) = r + gv[bj][n] * acc[ai][bj][m][n]; } }
    }
};
struct EpiSwiglu {
    static constexpr bool PERM = true, AFTER_DRAIN = false;
    bf16_t* O; int ldc, nN;
    __device__ __forceinline__ void operator()(const f32x4 (&acc)[2][2][4][2], const Unit& u, int wr, int wc, int fr, int fq) const {
        const int row0 = u.pm * BM + wr * 64 + fr, col0 = (u.pn % nN) * HALF + wc * 32 + 8 * fq;
#pragma unroll
        for (int ai = 0; ai < 2; ++ai)
#pragma unroll
            for (int m = 0; m < 4; ++m) {
                const f32x4 g0 = acc[ai][0][m][0], g1 = acc[ai][0][m][1], u0 = acc[ai][1][m][0], u1 = acc[ai][1][m][1];
                u32x4 w;
                w.x = cvt_pk_bf16(silu_f(g0[0]) * u0[0], silu_f(g0[1]) * u0[1]); w.y = cvt_pk_bf16(silu_f(g0[2]) * u0[2], silu_f(g0[3]) * u0[3]);
                w.z = cvt_pk_bf16(silu_f(g1[0]) * u1[0], silu_f(g1[1]) * u1[1]); w.w = cvt_pk_bf16(silu_f(g1[2]) * u1[2], silu_f(g1[3]) * u1[3]);
                *(u32x4*)(O + (size_t)(row0 + ai * HALF + m * 16) * ldc + col0) = w; }
    }
};
struct EpiStoreF32 {
    static constexpr bool PERM = false, AFTER_DRAIN = false;
    float* C; int ldc, nN;
    __device__ __forceinline__ void operator()(const f32x4 (&acc)[2][2][4][2], const Unit& u, int wr, int wc, int fr, int fq) const {
        const int row0 = u.pm * BM + wr * 64 + fr, col0 = (u.pn % nN) * BM + wc * 32 + 4 * fq;
#pragma unroll
        for (int ai = 0; ai < 2; ++ai)
#pragma unroll
            for (int m = 0; m < 4; ++m) { float* rowp = C + (size_t)(row0 + ai * HALF + m * 16) * ldc + col0;
#pragma unroll
                for (int bj = 0; bj < 2; ++bj)
#pragma unroll
                    for (int n = 0; n < 2; ++n) *(f32x4*)(rowp + bj * HALF + n * 16) = acc[ai][bj][m][n]; }
    }
};
__device__ __forceinline__ unsigned pk4_fp8(float a, float b, float c, float d) { int w = 0; w = __builtin_amdgcn_cvt_pk_fp8_f32(a, b, w, false); w = __builtin_amdgcn_cvt_pk_fp8_f32(c, d, w, true); return (unsigned)w; }
__device__ __forceinline__ float sat8(float x) { return __builtin_amdgcn_fmed3f(x, -448.0f, 448.0f); }
__device__ __forceinline__ unsigned pk4_fp8_sat(float a, float b, float c, float d) { return pk4_fp8(sat8(a), sat8(b), sat8(c), sat8(d)); }
struct EpiSwigluF8 {
    static constexpr bool PERM = true, AFTER_DRAIN = false;
    unsigned char* O; int ldc, nN; float sin, sout;
    __device__ __forceinline__ void operator()(const f32x4 (&acc)[2][2][4][2], const Unit& u, int wr, int wc, int fr, int fq) const {
        const int row0 = u.pm * BM + wr * 64 + fr, col0 = (u.pn % nN) * HALF + wc * 32 + 8 * fq;
        typedef unsigned u32x2_ __attribute__((ext_vector_type(2)));
#pragma unroll
        for (int ai = 0; ai < 2; ++ai)
#pragma unroll
            for (int m = 0; m < 4; ++m) {
                const f32x4 g0 = acc[ai][0][m][0] * sin, g1 = acc[ai][0][m][1] * sin, u0 = acc[ai][1][m][0] * (sin * sout), u1 = acc[ai][1][m][1] * (sin * sout);
                u32x2_ w;
                w.x = pk4_fp8_sat(silu_f(g0[0]) * u0[0], silu_f(g0[1]) * u0[1], silu_f(g0[2]) * u0[2], silu_f(g0[3]) * u0[3]);
                w.y = pk4_fp8_sat(silu_f(g1[0]) * u1[0], silu_f(g1[1]) * u1[1], silu_f(g1[2]) * u1[2], silu_f(g1[3]) * u1[3]);
                *(u32x2_*)(O + (size_t)(row0 + ai * HALF + m * 16) * ldc + col0) = w; }
    }
};
struct EpiStoreF32S {
    static constexpr bool PERM = false, AFTER_DRAIN = false;
    float* C; int ldc, nN; float s;
    __device__ __forceinline__ void operator()(const f32x4 (&acc)[2][2][4][2], const Unit& u, int wr, int wc, int fr, int fq) const {
        const int row0 = u.pm * BM + wr * 64 + fr, col0 = (u.pn % nN) * BM + wc * 32 + 4 * fq;
#pragma unroll
        for (int ai = 0; ai < 2; ++ai)
#pragma unroll
            for (int m = 0; m < 4; ++m) { float* rowp = C + (size_t)(row0 + ai * HALF + m * 16) * ldc + col0;
#pragma unroll
                for (int bj = 0; bj < 2; ++bj)
#pragma unroll
                    for (int n = 0; n < 2; ++n) *(f32x4*)(rowp + bj * HALF + n * 16) = acc[ai][bj][m][n] * s; }
    }
};
struct EpiStoreBf16S {
    static constexpr bool PERM = true, AFTER_DRAIN = false;
    bf16_t* O; int ldc, nN; float s;
    __device__ __forceinline__ void operator()(const f32x4 (&acc)[2][2][4][2], const Unit& u, int wr, int wc, int fr, int fq) const {
        const int row0 = u.pm * BM + wr * 64 + fr, col0 = (u.pn % nN) * BM + wc * 32 + 8 * fq;
#pragma unroll
        for (int ai = 0; ai < 2; ++ai)
#pragma unroll
            for (int m = 0; m < 4; ++m) { bf16_t* rowp = O + (size_t)(row0 + ai * HALF + m * 16) * ldc + col0;
#pragma unroll
                for (int bj = 0; bj < 2; ++bj) { const f32x4 v0 = acc[ai][bj][m][0] * s, v1 = acc[ai][bj][m][1] * s;
                    u32x4 w; w.x = cvt_pk_bf16(v0[0], v0[1]); w.y = cvt_pk_bf16(v0[2], v0[3]); w.z = cvt_pk_bf16(v1[0], v1[1]); w.w = cvt_pk_bf16(v1[2], v1[3]);
                    *(u32x4*)(rowp + bj * HALF) = w; } }
    }
};
struct MoeOrder {
    const PG8_LAS int* tb; int nN, G, c;
    __device__ __forceinline__ bool next(int i, Unit& u) const {
        const int L = i * G + c; if (L >= tb[8] * nN) return false;
        int e = 0;
#pragma unroll
        for (int q = 1; q < 8; ++q) if (L >= tb[q] * nN) e = q;
        const int t0 = tb[e], rt = tb[e + 1] - t0, idx = L - t0 * nN;
        u.pm = t0 + idx % rt; u.pn = e * nN + idx / rt; return true;
    }
    __device__ __forceinline__ void a_ready(const Unit&) const {}
    __device__ __forceinline__ void done(const Unit&) const {}
};


template <class Epi, class Sched, bool ALIGN_EPI = false, bool SP2 = false, bool FP8 = false>
__device__ __forceinline__ void gemm_phase(PG8_LAS unsigned char* lds, const Gemm g, const Sched& S, const Epi& E, const int wave_id) {
    int lane_; asm volatile("v_mbcnt_lo_u32_b32 %0, -1, 0\n\tv_mbcnt_hi_u32_b32 %0, -1, %0" : "=v"(lane_));
    const int wid = wave_id, lane = lane_, tid = wid * 64 + lane, wr = wid >> 2, wc = wid & 3, fr = lane & 15, fq = lane >> 4;
    const int K = g.K, nt = K / BK;
    unsigned voffA[2], voffB[2];
#pragma unroll
    for (int i = 0; i < 2; ++i) { int R, C; stage_rc(tid * 16 + i * 8192, R, C); const int Rb = Epi::PERM ? ((R & ~31) + perm32(R & 31)) : R;
        voffA[i] = (unsigned)(R * K + C) * 2u; voffB[i] = (unsigned)(Rb * K + C) * 2u; }
    const size_t kstep = (size_t)(BK * 2);
    const size_t hstep = (size_t)HALF * K * 2;
    const size_t tstep = 2 * hstep;
    const unsigned ldsw = (unsigned)wid * 1024u;
    const int aoff = lds_byte(wr * 64 + fr, fq * 8), boff = lds_byte(wc * 32 + fr, fq * 8);
#define PG8_SA(b, h) (((b) * 2 + (h)) * HTB)
#define PG8_SB(b, h) ((4 + (b) * 2 + (h)) * HTB)
#define PG8_STAGE(bufoff, gbase, voff) do { _Pragma("unroll") for (int _i = 0; _i < 2; ++_i) \
        __builtin_amdgcn_global_load_lds((const unsigned*)((const char*)(gbase) + (voff)[_i]), (PG8_LAS unsigned*)(lds + (bufoff) + ldsw + _i * 8192), 16, 0, 0); } while (0)
#define PG8_LDA(dst, b, h) do { _Pragma("unroll") for (int m = 0; m < 4; ++m) _Pragma("unroll") for (int k = 0; k < 2; ++k) dst[m][k] = *(const PG8_LAS bf16x8*)(lds + PG8_SA(b, h) + aoff + m * 2048 + k * 1024); } while (0)
#define PG8_LDB(dst, b, h) do { _Pragma("unroll") for (int n = 0; n < 2; ++n) _Pragma("unroll") for (int k = 0; k < 2; ++k) dst[n][k] = *(const PG8_LAS bf16x8*)(lds + PG8_SB(b, h) + boff + n * 2048 + k * 1024); } while (0)
#define PG8_MMA(ai, bj, At, Bt) do { __builtin_amdgcn_s_setprio(1); _Pragma("unroll") for (int m = 0; m < 4; ++m) _Pragma("unroll") for (int n = 0; n < 2; ++n) { \
        if constexpr (FP8) { typedef int i32x4_ __attribute__((ext_vector_type(4))); typedef int i32x8_ __attribute__((ext_vector_type(8))); \
            const i32x8_ b8_ = __builtin_shufflevector(__builtin_bit_cast(i32x4_, Bt[n][0]), __builtin_bit_cast(i32x4_, Bt[n][1]), 0, 1, 2, 3, 4, 5, 6, 7); \
            const i32x8_ a8_ = __builtin_shufflevector(__builtin_bit_cast(i32x4_, At[m][0]), __builtin_bit_cast(i32x4_, At[m][1]), 0, 1, 2, 3, 4, 5, 6, 7); \
            asm volatile("v_mfma_scale_f32_16x16x128_f8f6f4 %0, %1, %2, %0, %3, %3 op_sel_hi:[0,0,0]" : "+v"(acc[ai][bj][m][n]) : "v"(b8_), "v"(a8_), "v"(one8_)); } \
        else { _Pragma("unroll") for (int k = 0; k < 2; ++k) acc[ai][bj][m][n] = __builtin_amdgcn_mfma_f32_16x16x32_bf16(Bt[n][k], At[m][k], acc[ai][bj][m][n], 0, 0, 0); } } \
        __builtin_amdgcn_s_setprio(0); } while (0)
#define PG8_WAIT_V(n) asm volatile("s_waitcnt vmcnt(" #n ")" ::: "memory")
#define PG8_WAIT_L(n) asm volatile("s_waitcnt lgkmcnt(" #n ")" ::: "memory")
#define PG8_BAR __builtin_amdgcn_s_barrier()
#define PG8_SCHED __builtin_amdgcn_sched_barrier(0)
    const int one8_ = 0x7F7F7F7F;
    Unit cur, nxt; int ui = 0;
    if (!S.next(0, cur)) return;
    f32x4 acc[2][2][4][2];
#pragma unroll
    for (int a = 0; a < 2; ++a)
#pragma unroll
        for (int b = 0; b < 2; ++b)
#pragma unroll
            for (int m = 0; m < 4; ++m)
#pragma unroll
                for (int n = 0; n < 2; ++n) acc[a][b][m][n] = (f32x4){0.f, 0.f, 0.f, 0.f};
    bf16x8 At[4][2], B0[2][2], B1[2][2];
    const char* cA = (const char*)g.A + (size_t)cur.pm * tstep; const char* cB = (const char*)g.Bt + (size_t)cur.pn * tstep;
    S.a_ready(cur);
    if constexpr (SP2) {
        PG8_STAGE(PG8_SB(0, 0), cB, voffB); PG8_STAGE(PG8_SB(0, 1), cB + hstep, voffB); PG8_STAGE(PG8_SA(0, 0), cA, voffA); PG8_STAGE(PG8_SA(0, 1), cA + hstep, voffA);
        if (wr == 1) PG8_BAR;
        PG8_WAIT_V(2); PG8_BAR;
        PG8_STAGE(PG8_SB(1, 0), cB + kstep, voffB); PG8_STAGE(PG8_SA(1, 0), cA + kstep, voffA); PG8_STAGE(PG8_SB(1, 1), cB + hstep + kstep, voffB);
        PG8_WAIT_V(6); PG8_BAR;
    } else {
        PG8_STAGE(PG8_SB(0, 0), cB, voffB); PG8_STAGE(PG8_SA(0, 0), cA, voffA); PG8_STAGE(PG8_SB(0, 1), cB + hstep, voffB); PG8_STAGE(PG8_SA(0, 1), cA + hstep, voffA);
        if (wr == 1) PG8_BAR;
        PG8_WAIT_V(4); PG8_BAR;
        PG8_STAGE(PG8_SB(1, 0), cB + kstep, voffB); PG8_STAGE(PG8_SA(1, 0), cA + kstep, voffA); PG8_STAGE(PG8_SB(1, 1), cB + hstep + kstep, voffB);
        PG8_WAIT_V(6); PG8_BAR;
    }
    for (;;) {
        const bool has_next = S.next(ui + 1, nxt);
        const char* nA = has_next ? (const char*)g.A + (size_t)nxt.pm * tstep : cA; const char* nB = has_next ? (const char*)g.Bt + (size_t)nxt.pn * tstep : cB;
        for (int t = 0; t < nt; t += 2) {
            const bool last = (t == nt - 2);
            const char* a1 = cA + (size_t)(t + 1) * kstep;
            const char* a2 = last ? nA : cA + (size_t)(t + 2) * kstep; const char* b2 = last ? nB : cB + (size_t)(t + 2) * kstep;
            const char* a3 = a2 + kstep; const char* b3 = b2 + kstep;
            if (last && has_next) S.a_ready(nxt);
            if constexpr (SP2) {
            PG8_LDB(B0, 0, 0); PG8_LDB(B1, 0, 1); PG8_SCHED; PG8_LDA(At, 0, 0); PG8_STAGE(PG8_SA(1, 1), a1 + hstep, voffA);
            PG8_WAIT_V(8); PG8_WAIT_L(0); PG8_BAR; PG8_MMA(0, 0, At, B0); PG8_MMA(0, 1, At, B1); PG8_BAR; PG8_SCHED;
            PG8_LDA(At, 0, 1); PG8_STAGE(PG8_SB(0, 0), b2, voffB); PG8_STAGE(PG8_SB(0, 1), b2 + hstep, voffB); PG8_STAGE(PG8_SA(0, 0), a2, voffA);
            PG8_WAIT_V(8); PG8_WAIT_L(0); PG8_BAR; PG8_MMA(1, 0, At, B0); PG8_MMA(1, 1, At, B1); PG8_BAR; PG8_SCHED;
            PG8_LDB(B0, 1, 0); PG8_LDB(B1, 1, 1); PG8_SCHED; PG8_LDA(At, 1, 0); PG8_STAGE(PG8_SA(0, 1), a2 + hstep, voffA);
            PG8_WAIT_V(8); PG8_WAIT_L(0); PG8_BAR; PG8_MMA(0, 0, At, B0); PG8_MMA(0, 1, At, B1); PG8_BAR; PG8_SCHED;
            PG8_LDA(At, 1, 1); PG8_STAGE(PG8_SB(1, 0), b3, voffB); PG8_STAGE(PG8_SB(1, 1), b3 + hstep, voffB); PG8_STAGE(PG8_SA(1, 0), a3, voffA);
            PG8_WAIT_V(8); PG8_WAIT_L(0); PG8_BAR; PG8_MMA(1, 0, At, B0); PG8_MMA(1, 1, At, B1); PG8_BAR; PG8_SCHED;
            } else {
            PG8_LDB(B0, 0, 0); PG8_SCHED; PG8_LDA(At, 0, 0); PG8_STAGE(PG8_SA(1, 1), a1 + hstep, voffA);
            PG8_WAIT_L(8); PG8_BAR; PG8_WAIT_L(0); PG8_MMA(0, 0, At, B0); PG8_BAR; PG8_SCHED;
            PG8_LDB(B1, 0, 1); PG8_STAGE(PG8_SB(0, 0), b2, voffB);
            PG8_BAR; PG8_WAIT_L(0); PG8_MMA(0, 1, At, B1); PG8_BAR;
            PG8_LDA(At, 0, 1); PG8_STAGE(PG8_SA(0, 0), a2, voffA);
            PG8_BAR; PG8_WAIT_L(0); PG8_MMA(1, 0, At, B0); PG8_BAR; PG8_SCHED;
            PG8_STAGE(PG8_SB(0, 1), b2 + hstep, voffB);
            PG8_WAIT_V(6); PG8_BAR; PG8_MMA(1, 1, At, B1); PG8_BAR;
            PG8_LDB(B0, 1, 0); PG8_SCHED; PG8_LDA(At, 1, 0); PG8_STAGE(PG8_SA(0, 1), a2 + hstep, voffA);
            PG8_WAIT_L(8); PG8_BAR; PG8_WAIT_L(0); PG8_MMA(0, 0, At, B0); PG8_BAR; PG8_SCHED;
            PG8_LDB(B1, 1, 1); PG8_STAGE(PG8_SB(1, 0), b3, voffB);
            PG8_BAR; PG8_WAIT_L(0); PG8_MMA(0, 1, At, B1); PG8_BAR;
            PG8_LDA(At, 1, 1); PG8_STAGE(PG8_SA(1, 0), a3, voffA);
            PG8_BAR; PG8_WAIT_L(0); PG8_MMA(1, 0, At, B0); PG8_BAR; PG8_SCHED;
            PG8_STAGE(PG8_SB(1, 1), b3 + hstep, voffB);
            PG8_WAIT_V(6); PG8_BAR; PG8_MMA(1, 1, At, B1); PG8_BAR;
            }
        }
        if constexpr (FP8) asm volatile("s_nop 15\n\ts_nop 15" ::: "memory");
        if constexpr (ALIGN_EPI) { if (wr == 0) PG8_BAR; }
        if constexpr (!Epi::AFTER_DRAIN) { E(acc, cur, wr, wc, fr, fq); S.done(cur); }
        if (!has_next) break;
#pragma unroll
        for (int a = 0; a < 2; ++a)
#pragma unroll
            for (int b = 0; b < 2; ++b)
#pragma unroll
                for (int m = 0; m < 4; ++m)
#pragma unroll
                    for (int n = 0; n < 2; ++n) acc[a][b][m][n] = (f32x4){0.f, 0.f, 0.f, 0.f};
        cur = nxt; cA = nA; cB = nB; ++ui;
        if constexpr (ALIGN_EPI) { if (wr == 1) PG8_BAR; }
    }
    PG8_WAIT_V(0);
    if constexpr (!ALIGN_EPI) { if (wr == 0) PG8_BAR; }
    PG8_BAR;
    if constexpr (Epi::AFTER_DRAIN) { E.fused(acc, cur, wr, wc, fr, fq, lds, wid, lane); S.done(cur); }
#undef PG8_SA
#undef PG8_SB
#undef PG8_STAGE
#undef PG8_LDA
#undef PG8_LDB
#undef PG8_MMA
#undef PG8_WAIT_V
#undef PG8_WAIT_L
#undef PG8_BAR
#undef PG8_SCHED
}
}

#define LAS __attribute__((address_space(3)))
#define XB_TMO      128
#define XB_XCNT(j)  (256  + 64 * (j))
#define XB_XSUB(j)  (1280 + 64 * (j))
#define XB_XGEN(j)  (2304 + 64 * (j))
#define XB_TOP      3328
#define XB_TOPGEN   3392
#define XCD_BAR_WORDS 3456
#define XB_SPIN_CAP (1u << 18)

__device__ __forceinline__ unsigned xb_ld(unsigned* p)              { return __hip_atomic_load(p, __ATOMIC_RELAXED, __HIP_MEMORY_SCOPE_AGENT); }
__device__ __forceinline__ unsigned xb_add(unsigned* p, unsigned v) { return __hip_atomic_fetch_add(p, v, __ATOMIC_RELAXED, __HIP_MEMORY_SCOPE_AGENT); }
__device__ __forceinline__ unsigned xb_xcc_id() { return (unsigned)__builtin_amdgcn_s_getreg((3 << 11) | 20) & 0xFu; }
#define XB_SPIN(cond, bar) do { unsigned _sp = 0; while (cond) { __builtin_amdgcn_s_sleep(1); \
    if ((++_sp & 255u) == 0u) { if (xb_ld(&(bar)[XB_TMO])) break; if (_sp > XB_SPIN_CAP) { atomicAdd(&(bar)[XB_TMO], 1u); break; } } } } while (0)

struct XcdBarrier {
    unsigned* bar; unsigned x;
    volatile LAS unsigned* st;
};

__device__ __forceinline__ XcdBarrier xcd_barrier_post(unsigned* bar, volatile LAS unsigned* st) {
    XcdBarrier b; b.bar = bar; b.x = xb_xcc_id(); b.st = st;
    if (threadIdx.x == 0) (void)xb_add(&bar[XB_XCNT(b.x)], 1u);
    return b;
}
__device__ __forceinline__ void xcd_barrier_complete(unsigned* bar, unsigned x, unsigned& nloc, unsigned& nx) {
    const unsigned G = gridDim.x * gridDim.y * gridDim.z;
    unsigned sum, cnt, mine, sp = 0u;
    for (;;) {
        sum = 0u; cnt = 0u; mine = 0u;
#pragma unroll
        for (unsigned j = 0; j < 16; ++j) { const unsigned c = xb_ld(&bar[XB_XCNT(j)]); sum += c; cnt += (c > 0u) ? 1u : 0u; mine = (j == x) ? c : mine; }
        if (sum == G) break;
        __builtin_amdgcn_s_sleep(1);
        if ((++sp & 255u) == 0u) { if (xb_ld(&bar[XB_TMO])) break; if (sp > XB_SPIN_CAP) { atomicAdd(&bar[XB_TMO], 1u); break; } }
    }
    nloc = mine > 0u ? mine : 1u; nx = cnt > 0u ? cnt : 1u;
}

__device__ __forceinline__ void xcd_barrier(const XcdBarrier& b) {
    asm volatile("s_waitcnt vmcnt(0)" ::: "memory");
    __syncthreads();
    if (threadIdx.x == 0) {
        unsigned* bar = b.bar;
        __builtin_amdgcn_s_waitcnt(0);
        unsigned nloc = b.st[0], nx = b.st[1];
        if (nloc == 0u) { xcd_barrier_complete(bar, b.x, nloc, nx); b.st[0] = nloc; b.st[1] = nx; }
        const unsigned old = xb_add(&bar[XB_XSUB(b.x)], 1u);
        const unsigned gen = old / nloc;
        if (old + 1u == (gen + 1u) * nloc) {
            __builtin_amdgcn_fence(__ATOMIC_RELEASE, "agent");
            asm volatile("s_waitcnt vmcnt(0)" ::: "memory");
            const unsigned og = xb_add(&bar[XB_TOP], 1u);
            const unsigned tg = og / nx;
            if (og + 1u == (tg + 1u) * nx) xb_add(&bar[XB_TOPGEN], 1u);
            else XB_SPIN(xb_ld(&bar[XB_TOPGEN]) == tg, bar);
            __builtin_amdgcn_fence(__ATOMIC_ACQUIRE, "agent");
            xb_add(&bar[XB_XGEN(b.x)], 1u);
            asm volatile("s_waitcnt vmcnt(0)" ::: "memory");
        } else {
            XB_SPIN(xb_ld(&bar[XB_XGEN(b.x)]) == gen, bar);
            __builtin_amdgcn_fence(__ATOMIC_ACQUIRE, "agent");
            asm volatile("s_waitcnt vmcnt(0)" ::: "memory");
        }
    }
    __syncthreads();
}

#ifndef REP_PHASE
#define REP_PHASE -1
#endif
#define PH(k, ...) do { __VA_ARGS__; if (REP_PHASE == (k)) { xcd_barrier(bar); __VA_ARGS__; } } while (0)
namespace {
typedef unsigned short bf16;
typedef float f32x4 __attribute__((ext_vector_type(4)));
typedef float f32x2 __attribute__((ext_vector_type(2)));
typedef unsigned u32x4 __attribute__((ext_vector_type(4)));
typedef unsigned u32x2 __attribute__((ext_vector_type(2)));
typedef short bf16x8 __attribute__((ext_vector_type(8)));
constexpr int D = 2048, NB = 4, T = 2048, M = NB * T, C = 1024, H = 16, HN = 64;
constexpr int NR0 = 3360, NR1 = 3392, NP0 = NR0 + 3072, NP1 = NR1 + 3072, NPP = 6656;
constexpr int MH = 8, MD = 128, MBS = 256, NBLK = 8;
constexpr int FF = 5632, NE = 8, NFT = FF / 128;
constexpr int SLOTS = 2 * M + NE * 256;
constexpr int NWG = 256, NWAVE = 8, NGW = NWG * NWAVE;
constexpr int KSPLIT = 8;
constexpr int RING_BYTES = 131072, LDSCTL_OFF = RING_BYTES, LDS_BYTES = RING_BYTES + 1024;
constexpr size_t al(size_t x) { return (x + 4095) / 4096 * 4096; }
constexpr size_t WS_CTL = 0, CTL_BYTES = 1u << 20;
constexpr int CW_BAR = 1024, CW_CNT = 8192;
constexpr size_t WS_MODP = WS_CTL + CTL_BYTES;
constexpr size_t WS_MOD = WS_MODP + al((size_t)KSPLIT * 2 * NB * 6 * D * 4);
constexpr size_t WS_TOKE = WS_MOD + al((size_t)2 * NB * 6 * D * 4);
constexpr size_t WS_TOKP = WS_TOKE + al((size_t)2 * M * 4);
constexpr size_t WS_TOKW = WS_TOKP + al((size_t)2 * M * 4);
constexpr size_t WS_TOKS = WS_TOKW + al((size_t)2 * M * 4);
constexpr size_t WS_KMEAN = WS_TOKS + al((size_t)2 * M * 4);
constexpr size_t WS_RKB = WS_KMEAN + al((size_t)NB * MH * NBLK * MD * 4);
constexpr size_t WS_LW = WS_RKB + al((size_t)M * H * 4);
constexpr size_t WS_WIN = WS_LW + al((size_t)2 * C * 320 * 2);
constexpr size_t WS_WOUT = WS_WIN + al((size_t)2 * NPP * D * 2);
constexpr size_t WS_FGU = WS_WOUT + al((size_t)2 * D * D * 2);
constexpr size_t WS_FD = WS_FGU + al((size_t)2 * FF * D * 2);
constexpr size_t WS_EGU = WS_FD + al((size_t)D * FF * 2);
constexpr size_t WS_ED = WS_EGU + al((size_t)NE * 2 * FF * D * 2);
constexpr size_t WS_H = WS_ED + al((size_t)NE * D * FF * 2);
constexpr size_t WS_X1 = WS_H + al((size_t)M * D * 2);
constexpr size_t WS_X2 = WS_X1 + al((size_t)M * D * 4);
constexpr size_t WS_VF = WS_X2 + al((size_t)M * D * 4);
constexpr size_t WS_CAT = WS_VF + al((size_t)M * C * 4);
constexpr size_t WS_REG = WS_CAT + al((size_t)M * D * 2);
constexpr size_t MX_PROJ = 0;
constexpr size_t MX_SR = MX_PROJ + al((size_t)M * NPP * 2);
constexpr size_t SARR = al((size_t)M * C * 4);
constexpr size_t MX_SIN = MX_SR;
constexpr size_t MX_SV = MX_SIN + al((size_t)M * H * 320 * 4), MX_SG = MX_SV + SARR, MX_SY = MX_SG + SARR, MX_VT = MX_SY + SARR, MX_END = MX_VT + al((size_t)M * C * 2);
constexpr size_t FX_ACT = 0;
constexpr size_t FX_AMOE = FX_ACT + al((size_t)SLOTS * FF * 2);
constexpr size_t FX_OSLOT = FX_AMOE + al((size_t)SLOTS * D * 2);
constexpr size_t FX_END = FX_OSLOT + al((size_t)SLOTS * D * 4);
constexpr size_t WS_END = WS_REG + (MX_END > FX_END ? MX_END : FX_END);

struct Params { const float* in[48]; float* out; unsigned char* ws; };

template <int CTRL> __device__ __forceinline__ float dpp_mov(float v) { return __int_as_float(__builtin_amdgcn_update_dpp(0, __float_as_int(v), CTRL, 0xF, 0xF, true)); }
__device__ __forceinline__ float row16_sum(float v) {
    v += dpp_mov<0xB1>(v);
    v += dpp_mov<0x4E>(v);
    v += dpp_mov<0x141>(v);
    v += dpp_mov<0x140>(v);
    return v;
}
__device__ __forceinline__ float xor_lane(float v, int lane, int m) { return __int_as_float(__builtin_amdgcn_ds_bpermute((lane ^ m) << 2, __float_as_int(v))); }
__device__ __forceinline__ float wave_sum(float v, int lane) { v = row16_sum(v); v += xor_lane(v, lane, 16); v += xor_lane(v, lane, 32); return v; }
__device__ __forceinline__ float bf2f(bf16 b) { return __uint_as_float(((unsigned)b) << 16); }
__device__ __forceinline__ float bflo(unsigned w) { return __uint_as_float(w << 16); }
__device__ __forceinline__ float bfhi(unsigned w) { return __uint_as_float(w & 0xffff0000u); }
__device__ __forceinline__ unsigned pk_bf16(float lo, float hi) { return pg8::cvt_pk_bf16(lo, hi); }
__device__ __forceinline__ float sigmoid_f(float x) { return 1.0f / (1.0f + __expf(-x)); }
#define LDS_WAIT() asm volatile("s_waitcnt lgkmcnt(0)" ::: "memory")

struct Ctx { LAS unsigned char* lds; int tid, lane, wave, wg; };
__device__ __forceinline__ Ctx fresh_ctx(const Ctx& a) {
    Ctx c; int ln, w = a.wg; asm volatile("v_mbcnt_lo_u32_b32 %0, -1, 0\n\tv_mbcnt_hi_u32_b32 %0, -1, %0" : "=v"(ln)); asm volatile("" : "+v"(w));
    c.lds = a.lds; c.lane = ln; c.wave = a.wave; c.tid = a.wave * 64 + ln; c.wg = __builtin_amdgcn_readfirstlane(w); return c;
}
__device__ __forceinline__ unsigned char* fresh_ws(const struct Params& p);

__device__ __forceinline__ unsigned char* fresh_ws(const Params& p) {
    unsigned z = 0u; asm volatile("" : "+v"(z));
    return p.ws + (size_t)__builtin_amdgcn_readfirstlane(z);
}
__device__ __forceinline__ void p0_mod_item(const Params& p, const Ctx& c, int it, LAS float* scr) {
    const int ks = it % KSPLIT, cg = (it / KSPLIT) % 192, l = it / (KSPLIT * 192);
    const float* cc = p.in[1]; const float* mw = p.in[l ? 23 : 2];
    const int k0 = ks * 256;
#pragma unroll
    for (int b = 0; b < NB; ++b)
#pragma unroll
        for (int i = 0; i < 4; ++i) { const float v = cc[b * D + k0 + c.lane + 64 * i]; scr[(c.lane + 64 * i) * 4 + b] = v / (1.0f + __expf(-v)); }
    LDS_WAIT(); asm volatile("" ::: "memory");
    float a0 = 0.f, a1 = 0.f, a2 = 0.f, a3 = 0.f;
    const float* wp = mw + (size_t)k0 * (6 * D) + cg * 64 + c.lane;
#pragma unroll 16
    for (int k = 0; k < 256; ++k) { const float w = wp[(size_t)k * (6 * D)]; const f32x4 cv = *(const LAS f32x4*)(scr + 4 * k); a0 += cv[0] * w; a1 += cv[1] * w; a2 += cv[2] * w; a3 += cv[3] * w; }
    float* o = (float*)(p.ws + WS_MODP) + ((size_t)(ks * 2 + l) * NB) * (6 * D) + cg * 64 + c.lane;
    o[0] = a0; o[6 * D] = a1; o[2 * 6 * D] = a2; o[3 * 6 * D] = a3;
    LDS_WAIT(); asm volatile("" ::: "memory");
}
struct ConvJob { const float* src; unsigned char* dst; int K, N, kt, nt, dst_row0, f8; };
constexpr float W8_SCALE = 256.0f, A8_SCALE = 16.0f, H8_SCALE = 8.0f;
__device__ __forceinline__ void conv_issue(const ConvJob& j, f32x2 (&cv)[32], int lane) {
    const int n = j.nt * 64 + 2 * (lane & 31); const bool ok = n < j.N;
    const float* s = j.src + (size_t)(j.kt * 64 + 32 * (lane >> 5)) * j.N + (ok ? n : 0);
#pragma unroll
    for (int i = 0; i < 32; ++i) cv[i] = *(const f32x2*)(s + (size_t)i * j.N);
}
__device__ __forceinline__ void conv_finish(const ConvJob& j, f32x2 (&cv)[32], LAS unsigned* scr, int lane) {
    const int n2 = lane & 31, kh = lane >> 5; const bool ok = j.nt * 64 + 2 * n2 < j.N;
    if (j.f8) {
#pragma unroll
        for (int q = 0; q < 2; ++q)
#pragma unroll
            for (int i4 = 0; i4 < 8; ++i4) scr[(2 * n2 + q) * 17 + 8 * kh + i4] = pg8::pk4_fp8(cv[4 * i4][q] * W8_SCALE, cv[4 * i4 + 1][q] * W8_SCALE, cv[4 * i4 + 2][q] * W8_SCALE, cv[4 * i4 + 3][q] * W8_SCALE);
        LDS_WAIT(); asm volatile("" ::: "memory");
        const int cch = lane & 3;
#pragma unroll
        for (int jj = 0; jj < 4; ++jj) { const int nn = (lane >> 2) + 16 * jj; const LAS unsigned* qp = scr + nn * 17 + 4 * cch;
            u32x4 o; o.x = qp[0]; o.y = qp[1]; o.z = qp[2]; o.w = qp[3];
            *(u32x4*)(j.dst + (size_t)(j.dst_row0 + nn) * j.K + j.kt * 64 + 16 * cch) = o; }
    } else {
#pragma unroll
        for (int q = 0; q < 2; ++q)
#pragma unroll
            for (int i2 = 0; i2 < 16; ++i2) scr[(2 * n2 + q) * 33 + 16 * kh + i2] = ok ? pk_bf16(cv[2 * i2][q], cv[2 * i2 + 1][q]) : 0u;
        LDS_WAIT(); asm volatile("" ::: "memory");
        const int cch = lane & 7;
#pragma unroll
        for (int jj = 0; jj < 8; ++jj) { const int nn = (lane >> 3) + 8 * jj; const LAS unsigned* qp = scr + nn * 33 + 4 * cch;
            u32x4 o; o.x = qp[0]; o.y = qp[1]; o.z = qp[2]; o.w = qp[3];
            *(u32x4*)(j.dst + ((size_t)(j.dst_row0 + nn) * j.K + j.kt * 64 + 8 * cch) * 2) = o; }
    }
    LDS_WAIT(); asm volatile("" ::: "memory");
}
__device__ __forceinline__ int gu_row(int n) { return (n >> 7) * 256 + (n & 127); }
constexpr int I_MOD = 2 * 192 * KSPLIT;
constexpr int I_WIN = (NPP / 64) * (D / 64), I_WOUT = (D / 64) * (D / 64), I_FG = (FF / 64) * (D / 64), I_FD = (D / 64) * (FF / 64);
constexpr int BG_DENSE = I_WOUT + 2 * I_FG + I_FD + I_WIN + I_WOUT, BG_TOTAL = BG_DENSE + NE * (2 * I_FG + I_FD);
__device__ __forceinline__ ConvJob bg_job(const Params& p, unsigned char* ws, int r) {
    ConvJob j;
    if (r < I_WOUT) { j.src = p.in[18]; j.dst = ws + WS_WOUT; j.f8 = 0; j.K = D; j.N = D; j.nt = r % (D / 64); j.kt = r / (D / 64); j.dst_row0 = j.nt * 64; return j; } r -= I_WOUT;
    if (r < 2 * I_FG) { const int u = r / I_FG; r -= u * I_FG; j.src = p.in[20 + u]; j.dst = ws + WS_FGU; j.f8 = 0; j.K = D; j.N = FF; j.nt = r % (FF / 64); j.kt = r / (FF / 64); j.dst_row0 = gu_row(j.nt * 64) + u * 128; return j; } r -= 2 * I_FG;
    if (r < I_FD) { j.src = p.in[22]; j.dst = ws + WS_FD; j.f8 = 0; j.K = FF; j.N = D; j.nt = r % (D / 64); j.kt = r / (D / 64); j.dst_row0 = j.nt * 64; return j; } r -= I_FD;
    if (r < I_WIN) { j.src = p.in[26]; j.dst = ws + WS_WIN + (size_t)NPP * D * 2; j.f8 = 0; j.K = D; j.N = NP1; j.nt = r % (NPP / 64); j.kt = r / (NPP / 64); j.dst_row0 = j.nt * 64; return j; } r -= I_WIN;
    if (r < I_WOUT) { j.src = p.in[41]; j.dst = ws + WS_WOUT + (size_t)D * D * 2; j.f8 = 0; j.K = D; j.N = D; j.nt = r % (D / 64); j.kt = r / (D / 64); j.dst_row0 = j.nt * 64; return j; } r -= I_WOUT;
    const int e = r / (2 * I_FG + I_FD); r -= e * (2 * I_FG + I_FD);
    if (r < 2 * I_FG) { const int u = r / I_FG; r -= u * I_FG; j.src = p.in[44 + u] + (size_t)e * D * FF; j.dst = ws + WS_EGU + (size_t)e * 2 * FF * D; j.f8 = 1; j.K = D; j.N = FF; j.nt = r % (FF / 64); j.kt = r / (FF / 64); j.dst_row0 = gu_row(j.nt * 64) + u * 128; return j; } r -= 2 * I_FG;
    j.src = p.in[46] + (size_t)e * FF * D; j.dst = ws + WS_ED + (size_t)e * D * FF; j.f8 = 1; j.K = FF; j.N = D; j.nt = r % (D / 64); j.kt = r / (D / 64); j.dst_row0 = j.nt * 64; return j;
}
__device__ __forceinline__ void p0_prologue(const Params& p, const Ctx& c_) {
    const Ctx c = fresh_ctx(c_);
    LAS unsigned* scr = (LAS unsigned*)(c.lds + c.wave * 16384);
    constexpr int TOTAL = I_MOD + I_WIN;
    unsigned char* ws = fresh_ws(p);
    f32x2 cv[32];
    for (int it = c.wg * NWAVE + c.wave; it < TOTAL; it += NGW) {
        int r = it;
        if (r < I_MOD) { p0_mod_item(p, c, r, (LAS float*)scr); continue; } r -= I_MOD;
        ConvJob j; j.src = p.in[5]; j.dst = ws + WS_WIN; j.f8 = 0; j.K = D; j.N = NP0; j.nt = r % (NPP / 64); j.kt = r / (NPP / 64); j.dst_row0 = j.nt * 64;
        conv_issue(j, cv, c.lane); conv_finish(j, cv, scr, c.lane);
    }
    for (int idx = (c.wg * NWAVE + c.wave) * 64 + c.lane; idx < 2 * 320 * C; idx += NGW * 64) {
        const int l = idx / (320 * C), rem = idx % (320 * C), k = rem / C, col = rem % C;
        const int pb = l ? 23 : 2;
        float v = 0.f;
        if (k < 64) v = p.in[pb + 6][(size_t)k * C + col]; else if (k < 128) v = p.in[pb + 8][(size_t)(k - 64) * C + col]; else if (k < 288) v = p.in[pb + 9][(size_t)(k - 128) * C + col];
        else if (l) v = p.in[34][(size_t)(k - 288) * C + col];
        ((bf16*)(ws + WS_LW))[((size_t)l * C + col) * 320 + k] = (bf16)(pk_bf16(v, 0.f) & 0xffffu);
    }
}

template <bool FROM_PARTIALS, bool ROUTE>
__device__ __forceinline__ void norm_mod_phase(const Params& p, const Ctx& c_, const float* x, const float* gain, int l, int shift_off, bf16* hout, const float* router) {
    const Ctx c = fresh_ctx(c_);
    LAS float* sh = (LAS float*)c.lds; LAS float* sc = sh + D;
    const int b = c.wg / 64;
    unsigned char* ws = fresh_ws(p);
    if (FROM_PARTIALS) {
        const float* mp = (const float*)(ws + WS_MODP); const float* mb = p.in[l ? 24 : 3];
        for (int i = c.tid; i < 2 * D; i += 512) { const int j = shift_off + i;
            float s = mb[j];
#pragma unroll
            for (int ks = 0; ks < KSPLIT; ++ks) s += mp[((size_t)(ks * 2 + l) * NB + b) * (6 * D) + j];
            sh[i] = s; }
        if (c.tid < 384) { const int idx = c.wg * 384 + c.tid; const int ll = idx / (NB * 6 * D), rem = idx % (NB * 6 * D), bb = rem / (6 * D), j = rem % (6 * D);
            float s = p.in[ll ? 24 : 3][j];
#pragma unroll
            for (int ks = 0; ks < KSPLIT; ++ks) s += mp[((size_t)(ks * 2 + ll) * NB + bb) * (6 * D) + j];
            ((float*)(ws + WS_MOD))[idx] = s; }
    } else {
        const float* md = (const float*)(ws + WS_MOD) + ((size_t)l * NB + b) * (6 * D) + shift_off;
        for (int i = c.tid; i < 2 * D; i += 512) sh[i] = md[i];
    }
    __syncthreads();
    for (int i = 0; i < 4; ++i) {
        const int m = c.wg * 32 + c.wave + 8 * i;
        const f32x4* xr = (const f32x4*)(x + (size_t)m * D) + c.lane;
        float ss = 0.f;
#pragma unroll
        for (int j = 0; j < 8; ++j) { const f32x4 t = xr[64 * j]; ss += (t[0] * t[0] + t[1] * t[1]) + (t[2] * t[2] + t[3] * t[3]); }
        ss = wave_sum(ss, c.lane);
        const float rn = 1.0f / sqrtf(ss * (1.0f / D) + 1e-6f);
        float lg[NE];
        if (ROUTE) {
#pragma unroll
            for (int e = 0; e < NE; ++e) lg[e] = 0.f; }
        u32x2* ho = (u32x2*)(hout + (size_t)m * D) + c.lane;
#pragma unroll 2
        for (int j = 0; j < 8; ++j) {
            const int d = 4 * (c.lane + 64 * j);
            const f32x4 g = *(const f32x4*)(gain + d); const f32x4 s1 = *(const LAS f32x4*)(sh + d); const f32x4 s2 = *(const LAS f32x4*)(sc + d);
            const f32x4 xv = xr[64 * j];
            f32x4 hv;
#pragma unroll
            for (int q = 0; q < 4; ++q) hv[q] = xv[q] * rn * g[q] * (1.0f + s2[q]) + s1[q];
            u32x2 w; w.x = pk_bf16(hv[0], hv[1]); w.y = pk_bf16(hv[2], hv[3]); ho[64 * j] = w;
            if (ROUTE) {
#pragma unroll
                for (int q = 0; q < 4; ++q) { const f32x4 r0 = *(const f32x4*)(router + (size_t)(d + q) * NE), r1 = *(const f32x4*)(router + (size_t)(d + q) * NE + 4);
                    lg[0] += hv[q] * r0[0]; lg[1] += hv[q] * r0[1]; lg[2] += hv[q] * r0[2]; lg[3] += hv[q] * r0[3];
                    lg[4] += hv[q] * r1[0]; lg[5] += hv[q] * r1[1]; lg[6] += hv[q] * r1[2]; lg[7] += hv[q] * r1[3]; } }
        }
        if (ROUTE) {
#pragma unroll
            for (int e = 0; e < NE; ++e) lg[e] = wave_sum(lg[e], c.lane);
            if (c.lane == 0) {
                int e1 = 0; float v1 = lg[0];
#pragma unroll
                for (int e = 1; e < NE; ++e) if (lg[e] > v1) { v1 = lg[e]; e1 = e; }
                int e2 = -1; float v2 = 0.f;
#pragma unroll
                for (int e = 0; e < NE; ++e) if (e != e1 && (e2 < 0 || lg[e] > v2)) { v2 = lg[e]; e2 = e; }
                const float p2 = __expf(v2 - v1); const float w1 = 1.0f / (1.0f + p2), w2 = p2 / (1.0f + p2);
                unsigned* cnt = (unsigned*)(ws + WS_CTL) + CW_CNT;
                const int pos1 = (int)__hip_atomic_fetch_add(cnt + 64 * e1, 1u, __ATOMIC_RELAXED, __HIP_MEMORY_SCOPE_AGENT);
                const int pos2 = (int)__hip_atomic_fetch_add(cnt + 64 * e2, 1u, __ATOMIC_RELAXED, __HIP_MEMORY_SCOPE_AGENT);
                int* te = (int*)(ws + WS_TOKE); int* tp = (int*)(ws + WS_TOKP); float* tw = (float*)(ws + WS_TOKW);
                te[2 * m] = e1; te[2 * m + 1] = e2; tp[2 * m] = pos1; tp[2 * m + 1] = pos2; tw[2 * m] = w1; tw[2 * m + 1] = w2;
            }
        }
    }
    __syncthreads();
}
__device__ __forceinline__ void moe_gather_phase(const Params& p, const Ctx& c_) {
    const Ctx c = fresh_ctx(c_);
    unsigned char* ws = fresh_ws(p);
    LAS int* tb = (LAS int*)(c.lds + LDSCTL_OFF + 64);
    const unsigned* cnt = (const unsigned*)(ws + WS_CTL) + CW_CNT;
    if (c.tid == 0) { int o = 0; for (int e = 0; e < NE; ++e) { tb[e] = o; o += ((int)__hip_atomic_load(cnt + 64 * e, __ATOMIC_RELAXED, __HIP_MEMORY_SCOPE_AGENT) + 255) >> 8; } tb[NE] = o; }
    __syncthreads();
    const int* te = (const int*)(ws + WS_TOKE); const int* tp = (const int*)(ws + WS_TOKP); int* ts = (int*)(ws + WS_TOKS);
    const bf16* h = (const bf16*)(ws + WS_H); unsigned char* am = ws + WS_REG + FX_AMOE;
    for (int i = 0; i < 4; ++i) {
        const int m = c.wg * 32 + c.wave + 8 * i;
        const u32x4* src = (const u32x4*)(h + (size_t)m * D) + c.lane;
        u32x2 v[4];
#pragma unroll
        for (int j = 0; j < 4; ++j) { const u32x4 w = src[64 * j];
            v[j].x = pg8::pk4_fp8_sat(bflo(w.x) * A8_SCALE, bfhi(w.x) * A8_SCALE, bflo(w.y) * A8_SCALE, bfhi(w.y) * A8_SCALE);
            v[j].y = pg8::pk4_fp8_sat(bflo(w.z) * A8_SCALE, bfhi(w.z) * A8_SCALE, bflo(w.w) * A8_SCALE, bfhi(w.w) * A8_SCALE); }
#pragma unroll
        for (int q = 0; q < 2; ++q) {
            const int slot = tb[te[2 * m + q]] * 256 + tp[2 * m + q];
            u32x2* dst = (u32x2*)(am + (size_t)slot * D) + c.lane;
#pragma unroll
            for (int j = 0; j < 4; ++j) dst[64 * j] = v[j];
            if (c.lane == 0) ts[2 * m + q] = slot;
        }
    }
    if (c.wg < NE) {
        const int e = c.wg; const int r0 = tb[e] * 256 + (int)__hip_atomic_load(cnt + 64 * e, __ATOMIC_RELAXED, __HIP_MEMORY_SCOPE_AGENT), r1 = tb[e + 1] * 256;
        const u32x4 z = {0u, 0u, 0u, 0u};
        for (int r = r0 + c.wave; r < r1; r += NWAVE) { u32x4* dst = (u32x4*)(am + (size_t)r * D) + c.lane; dst[0] = z; dst[64] = z; }
    }
}

template <int L>
__device__ __forceinline__ void prep_phase(const Params& p, const Ctx& c_) {
    const Ctx c = fresh_ctx(c_);
    constexpr int PB = L ? 23 : 2, Q = PB + 10 + (L ? 2 : 0);
    unsigned char* ws = fresh_ws(p);
    const bf16* proj = (const bf16*)(ws + WS_REG + MX_PROJ);
    const float* mu = p.in[PB + 4]; const float* w0 = p.in[PB + 5]; const float* a0 = p.in[PB + 7];
    const float* v0 = L ? p.in[PB + 10] : nullptr;
    const float* k_k = p.in[Q + 0]; const float* k_a = p.in[Q + 1]; const float* r_k = p.in[Q + 2];
    const bf16* lw = (const bf16*)(ws + WS_LW) + (size_t)L * C * 320;
    unsigned char* sin_ = ws + WS_REG + MX_SIN; bf16* sV = (bf16*)(ws + WS_REG + MX_SV); bf16* sG = (bf16*)(ws + WS_REG + MX_SG);
    bf16* vf = (bf16*)(ws + WS_VF); float* rkb = (float*)(ws + WS_RKB);
    constexpr int LZB = 656;
    LAS unsigned char* lz = c.lds;
    const int m0 = c.wg * 32;
#pragma unroll 1
    for (int rep_ = 0; rep_ < (REP_PHASE == 33 ? 2 : 1); ++rep_)
    { const int tk = c.tid >> 4, sub = c.tid & 15, m = m0 + tk; const bool has_prev = (m % T) != 0;
      const bf16* cur = proj + (size_t)m * NPP + 3072; const bf16* prv = cur - NPP;
#pragma unroll
      for (int i = 0; i < 10; ++i) { const int ic = 2 * (sub + 16 * i);
          unsigned o = 0u;
          if (L == 1 || ic < 288) {
              const unsigned cw = *(const unsigned*)(cur + ic); const unsigned pw = has_prev ? *(const unsigned*)(prv + ic) : 0u; const f32x2 mm = *(const f32x2*)(mu + 3072 + ic);
              float z0 = bflo(cw) + (bflo(pw) - bflo(cw)) * mm[0], z1 = bfhi(cw) + (bfhi(pw) - bfhi(cw)) * mm[1];
              if (ic < 64) { z0 = 1.0f - 2.0f / (1.0f + __expf(2.0f * z0)); z1 = 1.0f - 2.0f / (1.0f + __expf(2.0f * z1)); }
              else if (ic >= 128 && ic < 288) { z0 = sigmoid_f(z0); z1 = sigmoid_f(z1); }
              o = pk_bf16(z0, z1); }
          *(LAS unsigned*)(lz + tk * LZB + ic * 2) = o; } }
    __syncthreads();
    const int lane = c.lane, ti = lane & 15, g = lane >> 4;
    f32x4 acc[4];
#define LORA_MMA(KOFF, KSTEPS) do { bf16x8 wf_[KSTEPS][4]; \
        _Pragma("unroll") for (int ks = 0; ks < (KSTEPS); ++ks) _Pragma("unroll") for (int ct = 0; ct < 4; ++ct) wf_[ks][ct] = *(const bf16x8*)(lw + (size_t)(cbase + 16 * ct + ti) * 320 + (KOFF) + 32 * ks + 8 * g); \
        __builtin_amdgcn_sched_barrier(0);     \
        _Pragma("unroll") for (int ct = 0; ct < 4; ++ct) acc[ct] = (f32x4){0.f, 0.f, 0.f, 0.f}; \
        _Pragma("unroll") for (int ks = 0; ks < (KSTEPS); ++ks) { \
            const bf16x8 af = *(const LAS bf16x8*)(lz + (16 * tt + ti) * LZB + ((KOFF) + 32 * ks + 8 * g) * 2); \
            _Pragma("unroll") for (int ct = 0; ct < 4; ++ct) acc[ct] = __builtin_amdgcn_mfma_f32_16x16x32_bf16(wf_[ks][ct], af, acc[ct], 0, 0, 0); } } while (0)
#define SHIFT4(seg, cl, out) do { const u32x2 cw_ = *(const LAS u32x2*)(stg + (ti + 1) * 400 + (seg) * 128 + (cl) * 2), pw_ = *(const LAS u32x2*)(stg + ti * 400 + (seg) * 128 + (cl) * 2); \
        const f32x4 mu_ = *(const LAS f32x4*)(prm + (seg) * 64 + (cl)); \
        out[0] = bflo(cw_.x) + (bflo(pw_.x) - bflo(cw_.x)) * mu_[0]; out[1] = bfhi(cw_.x) + (bfhi(pw_.x) - bfhi(cw_.x)) * mu_[1]; \
        out[2] = bflo(cw_.y) + (bflo(pw_.y) - bflo(cw_.y)) * mu_[2]; out[3] = bfhi(cw_.y) + (bfhi(pw_.y) - bfhi(cw_.y)) * mu_[3]; } while (0)
    LAS unsigned char* stg = c.lds + 24576 + c.wave * 9216;
    LAS float* prm = (LAS float*)(stg + 6912);
#pragma unroll 1
    for (int it_ = 0; it_ < (REP_PHASE == 31 ? 8 : 4); ++it_) {
        const int it = it_ & 3, tt = c.wave & 1;
        const int head = 4 * (c.wave >> 1) + it, cbase = 64 * head;
        const int m = m0 + 16 * tt + ti;
#pragma unroll 1
        for (int rep0_ = 0; rep0_ < (REP_PHASE == 38 ? 3 : 1); ++rep0_)
        { const int mr0 = m0 + 16 * tt - 1; const bool first_zero = ((m0 + 16 * tt) % T) == 0;
          u32x4 sv_[7]; f32x4 pv_[3];
#pragma unroll
          for (int i = 0; i < 7; ++i) { int id = lane + 64 * i; id = id < 17 * 24 ? id : 17 * 24 - 1; const int row = id / 24, ch = id % 24, seg = ch >> 3, part = ch & 7;
              const int rr_ = (first_zero && row == 0) ? 1 : row;
              sv_[i] = *(const u32x4*)(proj + (size_t)(mr0 + rr_) * NPP + seg * 1024 + cbase + part * 8); }
#pragma unroll
          for (int i = 0; i < 3; ++i) { int id = lane + 64 * i; id = id < (L ? 144 : 128) ? id : 0; const int pi = id >> 4, part = id & 15;
              const float* src = pi < 3 ? mu + pi * 1024 : pi == 3 ? w0 : pi == 4 ? a0 : pi == 5 ? k_k : pi == 6 ? k_a : pi == 7 ? r_k : v0;
              pv_[i] = *(const f32x4*)(src + cbase + part * 4); }
          __builtin_amdgcn_sched_barrier(0);
#pragma unroll
          for (int i = 0; i < 7; ++i) { const int id = lane + 64 * i; if (id < 17 * 24) { const int row = id / 24, ch = id % 24, seg = ch >> 3, part = ch & 7;
              u32x4 v = sv_[i]; if (first_zero && row == 0) v = (u32x4){0u, 0u, 0u, 0u};
              *(LAS u32x4*)(stg + row * 400 + seg * 128 + part * 16) = v; } }
#pragma unroll
          for (int i = 0; i < 3; ++i) { const int id = lane + 64 * i; if (id < (L ? 144 : 128)) *(LAS f32x4*)(prm + (id >> 4) * 64 + (id & 15) * 4) = pv_[i]; }
          LDS_WAIT(); asm volatile("" ::: "memory"); }
        unsigned char* srec = sin_ + ((size_t)((m / T) * H + head) * T + (m % T)) * 768;
#pragma unroll 1
        for (int rep1_ = 0; rep1_ < (REP_PHASE == 36 ? 3 : 1); ++rep1_) {
        LORA_MMA(0, 2);
#pragma unroll
        for (int ct = 0; ct < 4; ++ct) { const f32x4 b4 = *(const LAS f32x4*)(prm + 3 * 64 + 16 * ct + 4 * g); f32x4 o;
#pragma unroll
            for (int r = 0; r < 4; ++r) { const float nsw = -(acc[ct][r] + b4[r]); const float sp = nsw > 20.f ? nsw : __logf(1.0f + __expf(nsw)); o[r] = __expf(-__expf(-sp - 0.5f)); }
            *(f32x4*)(srec + (16 * ct + 4 * g) * 4) = o; }
        }
#pragma unroll 1
        for (int rep2_ = 0; rep2_ < (REP_PHASE == 35 ? 3 : 1); ++rep2_) {
        LORA_MMA(64, 2);
        { f32x4 kkv[4], av[4]; float ss = 0.f, bs = 0.f;
#pragma unroll
          for (int ct = 0; ct < 4; ++ct) { const int cl = 16 * ct + 4 * g;
              const f32x4 ab = *(const LAS f32x4*)(prm + 4 * 64 + cl), kk4 = *(const LAS f32x4*)(prm + 5 * 64 + cl), ka4 = *(const LAS f32x4*)(prm + 6 * 64 + cl), rk4 = *(const LAS f32x4*)(prm + 7 * 64 + cl);
              float rr[4], kv[4]; SHIFT4(0, cl, rr); SHIFT4(1, cl, kv);
              f32x4 km, r4;
#pragma unroll
              for (int r = 0; r < 4; ++r) { const float a_ = sigmoid_f(acc[ct][r] + ab[r]); av[ct][r] = a_; const float n_ = kv[r] * kk4[r]; kkv[ct][r] = n_; ss += n_ * n_;
                  km[r] = kv[r] * (1.0f + (a_ - 1.0f) * ka4[r]); r4[r] = rr[r]; bs += rr[r] * km[r] * rk4[r]; }
              *(u32x2*)(srec + 512 + (16 * ct + 4 * g) * 2) = (u32x2){pk_bf16(km[0], km[1]), pk_bf16(km[2], km[3])}; *(u32x2*)(srec + 640 + (16 * ct + 4 * g) * 2) = (u32x2){pk_bf16(r4[0], r4[1]), pk_bf16(r4[2], r4[3])}; }
          ss += xor_lane(ss, lane, 16); ss += xor_lane(ss, lane, 32); bs += xor_lane(bs, lane, 16); bs += xor_lane(bs, lane, 32);
          const float inv = 1.0f / sqrtf(fmaxf(ss, 1e-24f));
#pragma unroll
          for (int ct = 0; ct < 4; ++ct) { const f32x4 n4 = kkv[ct] * inv, nb = n4 * av[ct]; *(u32x2*)(srec + 256 + (16 * ct + 4 * g) * 2) = (u32x2){pk_bf16(-n4[0], -n4[1]), pk_bf16(-n4[2], -n4[3])};
              *(u32x2*)(srec + 384 + (16 * ct + 4 * g) * 2) = (u32x2){pk_bf16(nb[0], nb[1]), pk_bf16(nb[2], nb[3])}; }
          if (g == 0) rkb[(size_t)m * H + head] = bs; }
        }
#pragma unroll 1
        for (int rep_ = 0; rep_ < (REP_PHASE == 34 ? 3 : 1); ++rep_) {
        LORA_MMA(128, 5);
#pragma unroll
        for (int ct = 0; ct < 4; ++ct) *(u32x2*)(sG + (size_t)m * C + cbase + 16 * ct + 4 * g) = (u32x2){pk_bf16(acc[ct][0], acc[ct][1]), pk_bf16(acc[ct][2], acc[ct][3])};
        }
#pragma unroll 1
        for (int rep4_ = 0; rep4_ < (REP_PHASE == 37 ? 3 : 1); ++rep4_) {
        if (L == 1) LORA_MMA(288, 1);
#pragma unroll
        for (int ct = 0; ct < 4; ++ct) { const int cl = 16 * ct + 4 * g, c4 = cbase + cl; float vv[4]; SHIFT4(2, cl, vv); f32x4 o = {vv[0], vv[1], vv[2], vv[3]};
            const size_t off = (size_t)m * C + c4;
            if (L == 0) *(u32x2*)(vf + off) = (u32x2){pk_bf16(o[0], o[1]), pk_bf16(o[2], o[3])};
            else { const u32x2 fw = *(const u32x2*)(vf + off); const f32x4 f = {bflo(fw.x), bfhi(fw.x), bflo(fw.y), bfhi(fw.y)}, vb = *(const LAS f32x4*)(prm + 8 * 64 + cl);
#pragma unroll
                for (int r = 0; r < 4; ++r) o[r] = o[r] + (f[r] - o[r]) * sigmoid_f(acc[ct][r] + vb[r]); }
            *(u32x2*)(sV + off) = (u32x2){pk_bf16(o[0], o[1]), pk_bf16(o[2], o[3])}; }
        }
    }
#undef LORA_MMA
#undef SHIFT4
    __syncthreads();
#pragma unroll 1
    for (int rep_ = 0; rep_ < (REP_PHASE == 32 ? 2 : 1); ++rep_)
    { constexpr int NR = L ? NR1 : NR0;
      const int n = c.wg % NBLK, hh = (c.wg / NBLK) % MH, b = c.wg / (NBLK * MH);
      LAS float* red = (LAS float*)c.lds;
      const int d4 = c.tid & 31, rg = c.tid >> 5;
      float s0 = 0.f, s1 = 0.f, s2 = 0.f, s3 = 0.f;
      for (int i = 0; i < 16; ++i) { const u32x2 w = *(const u32x2*)(proj + (size_t)(b * T + n * MBS + rg * 16 + i) * NPP + NR + 1024 + hh * MD + 4 * d4);
          s0 += bflo(w.x); s1 += bfhi(w.x); s2 += bflo(w.y); s3 += bfhi(w.y); }
      *(LAS f32x4*)(red + rg * 128 + 4 * d4) = (f32x4){s0, s1, s2, s3};
      __syncthreads();
      if (c.tid < 128) { float s = 0.f;
#pragma unroll
          for (int i = 0; i < 16; ++i) s += red[i * 128 + c.tid];
          ((float*)(ws + WS_KMEAN))[(size_t)c.wg * MD + c.tid] = s * (1.0f / MBS); }
      __syncthreads();
      bf16* vt = (bf16*)(ws + WS_REG + MX_VT);
#pragma unroll
      for (int i = 0; i < 8; ++i) { const int id = c.tid + 512 * i, key = id >> 4, part = id & 15;
          const u32x4 v = *(const u32x4*)(proj + (size_t)(b * T + n * MBS + key) * NPP + NR + 2048 + hh * MD + part * 8);
          *(LAS u32x4*)(c.lds + key * 256 + part * 16) = v; }
      __syncthreads();
#pragma unroll
      for (int i = 0; i < 8; ++i) { const int d = c.lane + 64 * (i & 1), kc = c.wave + 8 * (i >> 1);
          const LAS unsigned short* q = (const LAS unsigned short*)(c.lds + (8 * kc) * 256 + 2 * d);
          u32x4 o; o.x = q[0] | ((unsigned)q[128] << 16); o.y = q[256] | ((unsigned)q[384] << 16); o.z = q[512] | ((unsigned)q[640] << 16); o.w = q[768] | ((unsigned)q[896] << 16);
          *(u32x4*)(vt + ((size_t)(b * MH + hh) * MD + d) * T + n * MBS + 8 * kc) = o; }
      __syncthreads(); }
}

template <int SCAN_ID>
__device__ __forceinline__ void scan_phase(const Params& p, const Ctx& c_) {
    const Ctx c = fresh_ctx(c_);
    unsigned char* ws = fresh_ws(p);
    const unsigned char* sin_ = ws + WS_REG + MX_SIN;
    const bf16* sV = (const bf16*)(ws + WS_REG + MX_SV); float* sY = (float*)(ws + WS_REG + MX_SY);
    const int xcd = c.wg & 7, j = c.wg >> 3, bh = xcd * 8 + (j >> 2), rq = j & 3, b = bh / H, h = bh % H;
    constexpr int TC = 32, NCH = T / TC, BUF = TC * 320;
    LAS float* inb = (LAS float*)c.lds;
    LAS float* vb = inb + 2 * BUF;
    LAS float* yb = vb + 2 * TC * 16;
    const unsigned char* src = sin_ + (size_t)bh * T * 768;
    constexpr int CHB = TC * 768;
#define SCAN_PARK(bufbase) do { _Pragma("unroll") for (int i = 0; i < 6; ++i) { const int pid = tl + 256 * i, t_ = pid / 48, pp = pid % 48; LAS float* d_ = (bufbase) + t_ * 320; \
        if (pp < 16) *(LAS f32x4*)(d_ + 64 + 4 * pp) = __builtin_bit_cast(f32x4, pre[i]); \
        else { const int qq = (pp - 16) >> 3, col = 8 * ((pp - 16) & 7), qd = qq == 0 ? 0 : qq + 1; const u32x4 w_ = pre[i]; \
            *(LAS f32x4*)(d_ + qd * 64 + col) = (f32x4){bflo(w_.x), bfhi(w_.x), bflo(w_.y), bfhi(w_.y)}; *(LAS f32x4*)(d_ + qd * 64 + col + 4) = (f32x4){bflo(w_.z), bfhi(w_.z), bflo(w_.w), bfhi(w_.w)}; } } } while (0)
    const size_t gv = (size_t)b * T * C + h * HN + 16 * rq;
    const bool loader = c.wave >= 4;
    const int tl = c.tid - 256;
    u32x4 pre[6]; float pv0 = 0.f, pv1 = 0.f;
    LAS unsigned* bscr = (LAS unsigned*)(c.lds + 90112 + (c.wave & 3) * 8448);
    const int lwid = c.wg * 4 + (c.wave & 3);
    if (loader) {
#pragma unroll
        for (int i = 0; i < 6; ++i) pre[i] = *(const u32x4*)(src + 16 * (tl + 256 * i));
        pv0 = bf2f(sV[gv + (size_t)(tl >> 4) * C + (tl & 15)]); pv1 = bf2f(sV[gv + (size_t)(16 + (tl >> 4)) * C + (tl & 15)]);
        SCAN_PARK(inb);
        vb[tl] = pv0; vb[256 + tl] = pv1;
#pragma unroll
        for (int i = 0; i < 6; ++i) pre[i] = *(const u32x4*)(src + (size_t)CHB + 16 * (tl + 256 * i));
        pv0 = bf2f(sV[gv + (size_t)(TC + (tl >> 4)) * C + (tl & 15)]); pv1 = bf2f(sV[gv + (size_t)(TC + 16 + (tl >> 4)) * C + (tl & 15)]);
    }
    const int rs = c.lane >> 4, cg = c.lane & 15;
    __syncthreads();
    if (!loader) {
        f32x4 S = {0.f, 0.f, 0.f, 0.f};
        __builtin_amdgcn_s_setprio(3);
        for (int ch = 0; ch < NCH; ++ch) {
            const int cur = ch & 1;
            const LAS float* ib = inb + cur * BUF + 4 * cg; const LAS float* vv = vb + cur * TC * 16 + 4 * c.wave + rs;
            LAS float* yo = yb + cur * TC * 16 + 4 * c.wave + rs;
            f32x4 a4 = *(const LAS f32x4*)(ib), w4 = *(const LAS f32x4*)(ib + 64), b4 = *(const LAS f32x4*)(ib + 128), k4 = *(const LAS f32x4*)(ib + 192), r4 = *(const LAS f32x4*)(ib + 256);
            float vi = vv[0];
            float yacc = 0.f;
#pragma unroll
            for (int t = 0; t < TC; ++t) {
                f32x4 a4n = a4, w4n = w4, b4n = b4, k4n = k4, r4n = r4; float vin = vi;
                if (t + 1 < TC) { const LAS float* nb = ib + (t + 1) * 320;
                    a4n = *(const LAS f32x4*)(nb); w4n = *(const LAS f32x4*)(nb + 64); b4n = *(const LAS f32x4*)(nb + 128); k4n = *(const LAS f32x4*)(nb + 192); r4n = *(const LAS f32x4*)(nb + 256); vin = vv[(t + 1) * 16]; }
                float sa = (S[0] * a4[0] + S[1] * a4[1]) + (S[2] * a4[2] + S[3] * a4[3]);
                sa = row16_sum(sa);
                S = S * w4 + sa * b4 + vi * k4;
                float y = (S[0] * r4[0] + S[1] * r4[1]) + (S[2] * r4[2] + S[3] * r4[3]);
                y = row16_sum(y);
                yacc = (cg == (t & 15)) ? y : yacc;
                if ((t & 15) == 15) yo[((t & 16) + cg) * 16] = yacc;
                a4 = a4n; w4 = w4n; b4 = b4n; k4 = k4n; r4 = r4n; vi = vin;
            }
            __syncthreads();
        }
        __builtin_amdgcn_s_setprio(0);
    } else {
        f32x2 cvA[32], cvB[32]; ConvJob bjA, bjB; bool pendA = false, pendB = false;
        constexpr int BG_HALF = (BG_TOTAL + 1) / 2;
#define SCAN_LOADER_ITER(ch_, cvX, bjX, pendX) do { const int cur = (ch_) & 1; \
            if ((ch_) + 1 < NCH) { SCAN_PARK(inb + (cur ^ 1) * BUF); vb[(cur ^ 1) * TC * 16 + tl] = pv0; vb[(cur ^ 1) * TC * 16 + 256 + tl] = pv1; } \
            if ((ch_) + 2 < NCH) { const unsigned char* s2 = src + (size_t)((ch_) + 2) * CHB; \
                _Pragma("unroll") for (int i = 0; i < 6; ++i) pre[i] = *(const u32x4*)(s2 + 16 * (tl + 256 * i)); \
                const size_t o = gv + (size_t)(((ch_) + 2) * TC) * C; \
                pv0 = bf2f(sV[o + (size_t)(tl >> 4) * C + (tl & 15)]); pv1 = bf2f(sV[o + (size_t)(16 + (tl >> 4)) * C + (tl & 15)]); } \
            if ((ch_) > 0) { const size_t o = gv + (size_t)(((ch_) - 1) * TC) * C; const LAS float* ys = yb + (cur ^ 1) * TC * 16; \
                sY[o + (size_t)(tl >> 4) * C + (tl & 15)] = ys[tl]; sY[o + (size_t)(16 + (tl >> 4)) * C + (tl & 15)] = ys[256 + tl]; } \
            if (pendX) { conv_finish(bjX, cvX, bscr, c.lane); pendX = false; } \
            if (((ch_) & 7) < 5) { const int bi = SCAN_ID * BG_HALF + (((ch_) >> 3) * 5 + ((ch_) & 7)) * (NWG * 4) + lwid; \
                if (bi < (SCAN_ID ? BG_TOTAL : BG_HALF)) { bjX = bg_job(p, ws, bi); conv_issue(bjX, cvX, c.lane); pendX = true; } } \
            __syncthreads(); } while (0)
        for (int ch = 0; ch < NCH; ch += 2) { SCAN_LOADER_ITER(ch, cvA, bjA, pendA); SCAN_LOADER_ITER(ch + 1, cvB, bjB, pendB); }
#undef SCAN_LOADER_ITER
        { const size_t o = gv + (size_t)((NCH - 1) * TC) * C; const LAS float* ys = yb + ((NCH - 1) & 1) * TC * 16;
          sY[o + (size_t)(tl >> 4) * C + (tl & 15)] = ys[tl]; sY[o + (size_t)(16 + (tl >> 4)) * C + (tl & 15)] = ys[256 + tl];
          if (pendA) conv_finish(bjA, cvA, bscr, c.lane); if (pendB) conv_finish(bjB, cvB, bscr, c.lane); }
    }
    __syncthreads();
#undef SCAN_PARK
}


template <int L>
__device__ __forceinline__ void mix_post_phase(const Params& p, const Ctx& c_) {
    const Ctx c = fresh_ctx(c_);
    constexpr int PB = L ? 23 : 2, Q = PB + 10 + (L ? 2 : 0);
    unsigned char* ws = fresh_ws(p);
    const float* ln_w = p.in[Q + 3]; const float* ln_b = p.in[Q + 4];
    const float* sY = (const float*)(ws + WS_REG + MX_SY); const bf16* sV = (const bf16*)(ws + WS_REG + MX_SV); const bf16* sG = (const bf16*)(ws + WS_REG + MX_SG);
    const float* rkb = (const float*)(ws + WS_RKB); bf16* cat = (bf16*)(ws + WS_CAT);
    const int gw = c.wg * NWAVE + c.wave, hl = c.lane >> 4;
    for (int it = gw; it < 4 * M; it += NGW) {
        const int m = it >> 2, ch = (it & 3) * 256 + 4 * c.lane, h = ch >> 6;
        const size_t o = (size_t)m * C + ch;
        const f32x4 y = *(const f32x4*)(sY + o);
        const u32x2 vw = *(const u32x2*)(sV + o), gw_ = *(const u32x2*)(sG + o);
        const f32x4 lw4 = *(const f32x4*)(ln_w + ch), lb4 = *(const f32x4*)(ln_b + ch);
        const float bon = rkb[(size_t)m * H + h];
        const float mean = row16_sum((y[0] + y[1]) + (y[2] + y[3])) * (1.0f / 64.0f);
        const f32x4 dy = y - mean;
        const float var = row16_sum((dy[0] * dy[0] + dy[1] * dy[1]) + (dy[2] * dy[2] + dy[3] * dy[3])) * (1.0f / 64.0f);
        const float rs = 1.0f / sqrtf(var + 64e-5f);
        const f32x4 v4 = {bflo(vw.x), bfhi(vw.x), bflo(vw.y), bfhi(vw.y)}, g4 = {bflo(gw_.x), bfhi(gw_.x), bflo(gw_.y), bfhi(gw_.y)};
        const f32x4 ov = (dy * rs * lw4 + lb4 + bon * v4) * g4;
        *(u32x2*)(cat + (size_t)m * D + ch) = (u32x2){pk_bf16(ov[0], ov[1]), pk_bf16(ov[2], ov[3])};
    }
    (void)hl;
    __syncthreads();
}

template <int L>
__device__ __forceinline__ void moba_phase(const Params& p, const Ctx& c_) {
    const Ctx c = fresh_ctx(c_);
    constexpr int PB = L ? 23 : 2, Q = PB + 10 + (L ? 2 : 0), NR = L ? NR1 : NR0;
    unsigned char* ws = fresh_ws(p);
    const bf16* proj = (const bf16*)(ws + WS_REG + MX_PROJ); const bf16* vt = (const bf16*)(ws + WS_REG + MX_VT);
    const float* kmean = (const float*)(ws + WS_KMEAN); const float* gain = p.in[Q + 5]; bf16* cat = (bf16*)(ws + WS_CAT);
    const int hf0 = c.wg & 1, pr = (c.wg >> 1) & 3, h = (c.wg >> 3) & 7, b = c.wg >> 6;
    const int lane = c.lane, qi = lane & 15, g = lane >> 4;
    const float slope = exp2f(-(float)(h + 1)), scale = 0.08838834764831845f;
    constexpr int KROW = 272, VROW = 144, KBUF = 64 * KROW, VBUF = 128 * VROW;
    LAS unsigned char* KB = c.lds; LAS unsigned char* VB = c.lds + 2 * KBUF;
    const bf16* kbase = proj + (size_t)(b * T) * NPP + NR + 1024 + h * MD;
    const bf16* vbase = vt + (size_t)(b * MH + h) * MD * T;
    u32x4 stg[4];
#define MOBA_LOAD(key0) do { _Pragma("unroll") for (int i_ = 0; i_ < 2; ++i_) { const int id_ = c.tid + 512 * i_; \
        stg[i_] = *(const u32x4*)(kbase + (size_t)((key0) + (id_ >> 4)) * NPP + (id_ & 15) * 8); \
        stg[2 + i_] = *(const u32x4*)(vbase + (size_t)(id_ >> 3) * T + (key0) + (id_ & 7) * 8); } } while (0)
#define MOBA_STORE(buf) do { _Pragma("unroll") for (int i_ = 0; i_ < 2; ++i_) { const int id_ = c.tid + 512 * i_; \
        *(LAS u32x4*)(KB + (buf) * KBUF + (id_ >> 4) * KROW + (id_ & 15) * 16) = stg[i_]; \
        *(LAS u32x4*)(VB + (buf) * VBUF + (id_ >> 3) * VROW + (id_ & 7) * 16) = stg[2 + i_]; } } while (0)
    for (int uu = 0; uu < 2; ++uu) {
        const int own = uu ? 7 - pr : pr, hf = uu ? 1 - hf0 : hf0;
        const int tq = own * MBS + hf * 128 + 16 * c.wave + qi;
        const size_t mrow = (size_t)(b * T + tq);
        bf16x8 qf[4];
#pragma unroll
        for (int ds = 0; ds < 4; ++ds) qf[ds] = *(const bf16x8*)(proj + mrow * NPP + NR + h * MD + 32 * ds + 8 * g);
        unsigned selmask = 0u;
        {
            float gt[8];
#pragma unroll
            for (int n = 0; n < 8; ++n) {
                float s = 0.f;
                if (n < own) {
                    const float* km = kmean + ((size_t)(b * MH + h) * NBLK + n) * MD + 8 * g;
#pragma unroll
                    for (int ds = 0; ds < 4; ++ds) { const f32x4 k0 = *(const f32x4*)(km + 32 * ds), k1 = *(const f32x4*)(km + 32 * ds + 4);
                        const u32x4 qw = __builtin_bit_cast(u32x4, qf[ds]);
                        s += bflo(qw.x) * k0[0] + bfhi(qw.x) * k0[1] + bflo(qw.y) * k0[2] + bfhi(qw.y) * k0[3] + bflo(qw.z) * k1[0] + bfhi(qw.z) * k1[1] + bflo(qw.w) * k1[2] + bfhi(qw.w) * k1[3]; }
                    s += xor_lane(s, lane, 16); s += xor_lane(s, lane, 32);
                }
                gt[n] = s;
            }
            const int nsel = own < 3 ? own : 3;
#pragma unroll
            for (int s = 0; s < 3; ++s) if (s < nsel) {
                int best = -1; float bv = 0.f;
#pragma unroll
                for (int n = 0; n < 8; ++n) { const bool cand = (n < own) && !((selmask >> n) & 1u); if (cand && (best < 0 || gt[n] > bv)) { best = n; bv = gt[n]; } }
                selmask |= 1u << best;
            }
        }
        const int nsteps = own * 4 + (hf ? 4 : 2);
        float m_run = -1e30f, l_run = 0.f;
        f32x4 acc[8];
#pragma unroll
        for (int dt = 0; dt < 8; ++dt) acc[dt] = (f32x4){0.f, 0.f, 0.f, 0.f};
        __syncthreads();
        MOBA_LOAD(0); MOBA_STORE(0);
        __syncthreads();
        for (int step = 0; step < nsteps; ++step) {
            const int kb = step >> 2, key0 = step * 64, buf = step & 1;
            if (step + 1 < nsteps) MOBA_LOAD(key0 + 64);
            const bool mine = (kb == own) || ((selmask >> kb) & 1u);
            if (__any(mine)) {
                const LAS unsigned char* kt_ = KB + buf * KBUF + qi * KROW + 16 * g;
                f32x4 st[4];
#pragma unroll
                for (int kt = 0; kt < 4; ++kt) { st[kt] = (f32x4){0.f, 0.f, 0.f, 0.f};
#pragma unroll
                    for (int ds = 0; ds < 4; ++ds) { const bf16x8 kf = *(const LAS bf16x8*)(kt_ + kt * 16 * KROW + ds * 64); st[kt] = __builtin_amdgcn_mfma_f32_16x16x32_bf16(kf, qf[ds], st[kt], 0, 0, 0); } }
                const float base = slope * (float)(key0 + 4 * g - tq);
                float mx = -1e30f;
#pragma unroll
                for (int kt = 0; kt < 4; ++kt)
#pragma unroll
                    for (int r = 0; r < 4; ++r) { const int kp = key0 + 16 * kt + 4 * g + r;
                        const float sv = st[kt][r] * scale + (base + slope * (float)(16 * kt + r));
                        const bool ok = mine && (kb < own || kp <= tq);
                        st[kt][r] = ok ? sv : -1e30f; mx = fmaxf(mx, st[kt][r]); }
                mx = fmaxf(mx, xor_lane(mx, lane, 16)); mx = fmaxf(mx, xor_lane(mx, lane, 32));
                const float m_new = fmaxf(m_run, mx);
                const float alpha = __expf(m_run - m_new);
                m_run = m_new;
                float ps = 0.f;
#pragma unroll
                for (int kt = 0; kt < 4; ++kt)
#pragma unroll
                    for (int r = 0; r < 4; ++r) { const float pv = (st[kt][r] > -1e29f) ? __expf(st[kt][r] - m_new) : 0.f; st[kt][r] = pv; ps += pv; }
                l_run = l_run * alpha + ps;
#pragma unroll
                for (int dt = 0; dt < 8; ++dt) acc[dt] = acc[dt] * alpha;
                const LAS unsigned char* vt_ = VB + buf * VBUF + qi * VROW + 8 * g;
#pragma unroll
                for (int kk = 0; kk < 2; ++kk) {
                    u32x4 pw; pw.x = pk_bf16(st[2 * kk][0], st[2 * kk][1]); pw.y = pk_bf16(st[2 * kk][2], st[2 * kk][3]); pw.z = pk_bf16(st[2 * kk + 1][0], st[2 * kk + 1][1]); pw.w = pk_bf16(st[2 * kk + 1][2], st[2 * kk + 1][3]);
                    const bf16x8 pf = __builtin_bit_cast(bf16x8, pw);
#pragma unroll
                    for (int dt = 0; dt < 8; ++dt) { const u32x2 v0 = *(const LAS u32x2*)(vt_ + dt * 16 * VROW + kk * 64), v1 = *(const LAS u32x2*)(vt_ + dt * 16 * VROW + kk * 64 + 32);
                        u32x4 vw; vw.x = v0.x; vw.y = v0.y; vw.z = v1.x; vw.w = v1.y;
                        acc[dt] = __builtin_amdgcn_mfma_f32_16x16x32_bf16(__builtin_bit_cast(bf16x8, vw), pf, acc[dt], 0, 0, 0); }
                }
            }
            if (step + 1 < nsteps) MOBA_STORE(buf ^ 1);
            __syncthreads();
        }
        l_run += xor_lane(l_run, lane, 16); l_run += xor_lane(l_run, lane, 32);
        const float inv = 1.0f / l_run;
        float ss = 0.f;
#pragma unroll
        for (int dt = 0; dt < 8; ++dt) { acc[dt] = acc[dt] * inv; ss += (acc[dt][0] * acc[dt][0] + acc[dt][1] * acc[dt][1]) + (acc[dt][2] * acc[dt][2] + acc[dt][3] * acc[dt][3]); }
        ss += xor_lane(ss, lane, 16); ss += xor_lane(ss, lane, 32);
        const float rn = 1.0f / sqrtf(ss * (1.0f / MD) + 1e-6f);
        bf16* op = cat + mrow * D + C + h * MD + 4 * g;
#pragma unroll
        for (int dt = 0; dt < 8; ++dt) { const f32x4 gg = *(const f32x4*)(gain + h * MD + 16 * dt + 4 * g);
            u32x2 w; w.x = pk_bf16(acc[dt][0] * rn * gg[0], acc[dt][1] * rn * gg[1]); w.y = pk_bf16(acc[dt][2] * rn * gg[2], acc[dt][3] * rn * gg[3]);
            *(u32x2*)(op + 16 * dt) = w; }
    }
#undef MOBA_LOAD
#undef MOBA_STORE
    __syncthreads();
}

__device__ __forceinline__ void final_phase(const Params& p, const Ctx& c_) {
    const Ctx c = fresh_ctx(c_);
    unsigned char* ws = fresh_ws(p);
    const float* x1 = (const float*)(ws + WS_X1); const bf16* os = (const bf16*)(ws + WS_REG + FX_OSLOT);
    const int* ts = (const int*)(ws + WS_TOKS); const float* tw = (const float*)(ws + WS_TOKW); const float* gain = p.in[47];
    for (int i = 0; i < 4; ++i) {
        const int m = c.wg * 32 + c.wave + 8 * i, b = m / T;
        const float* gt = (const float*)(ws + WS_MOD) + ((size_t)1 * NB + b) * (6 * D) + 5 * D;
        const int s1 = ts[2 * m], s2 = ts[2 * m + 1]; const float w1 = tw[2 * m], w2 = tw[2 * m + 1];
        const f32x4* xr = (const f32x4*)(x1 + (size_t)m * D) + c.lane; const u32x2* o1 = (const u32x2*)(os + (size_t)s1 * D) + c.lane; const u32x2* o2 = (const u32x2*)(os + (size_t)s2 * D) + c.lane;
        const f32x4* gp = (const f32x4*)gt + c.lane;
        f32x4 v[8]; float ss = 0.f;
#pragma unroll
        for (int j = 0; j < 8; ++j) { const u32x2 a = o1[64 * j], bq = o2[64 * j];
            const f32x4 e1 = {bflo(a.x), bfhi(a.x), bflo(a.y), bfhi(a.y)}, e2 = {bflo(bq.x), bfhi(bq.x), bflo(bq.y), bfhi(bq.y)};
            v[j] = xr[64 * j] + gp[64 * j] * (w1 * e1 + w2 * e2); ss += (v[j][0] * v[j][0] + v[j][1] * v[j][1]) + (v[j][2] * v[j][2] + v[j][3] * v[j][3]); }
        ss = wave_sum(ss, c.lane);
        const float rn = 1.0f / sqrtf(ss * (1.0f / D) + 1e-6f);
        f32x4* op = (f32x4*)(p.out + (size_t)m * D) + c.lane;
#pragma unroll
        for (int j = 0; j < 8; ++j) op[64 * j] = v[j] * rn * ((const f32x4*)gain)[c.lane + 64 * j];
    }
}

template <int L>
__device__ __forceinline__ void layer_phases(const Params& p, const Ctx& c, const XcdBarrier& bar, const float* xin) {
    constexpr int PB = L ? 23 : 2, Q = PB + 10 + (L ? 2 : 0);
    unsigned char* ws = fresh_ws(p);
    bf16* hb = (bf16*)(ws + WS_H);
    const float* modl = (const float*)(ws + WS_MOD) + (size_t)L * NB * 6 * D;
    PH(1, norm_mod_phase<L == 0, false>(p, c, xin, p.in[PB + 2], L, 0, hb, nullptr));
    xcd_barrier(bar);
    { pg8::Gemm g{hb, (const bf16*)(ws + WS_WIN) + (size_t)L * NPP * D, M, NPP, D}; pg8::StaticOrder S; S.init(M, NPP, NWG, c.wg);
      pg8::EpiStoreBf16 E{(bf16*)(ws + WS_REG + MX_PROJ), NPP};
      PH(2, pg8::gemm_phase<pg8::EpiStoreBf16, pg8::StaticOrder, true, true>(c.lds, g, S, E, c.wave)); }
    xcd_barrier(bar);
    PH(3, prep_phase<L>(p, c));
    xcd_barrier(bar);
    PH(4, scan_phase<L>(p, c));
    xcd_barrier(bar);
    PH(5, mix_post_phase<L>(p, c));
    PH(11, moba_phase<L>(p, c));
    xcd_barrier(bar);
    { pg8::Gemm g{(const bf16*)(ws + WS_CAT), (const bf16*)(ws + WS_WOUT) + (size_t)L * D * D, M, D, D}; pg8::StaticOrder S; S.init(M, D, NWG, c.wg);
      pg8::EpiResid E{(float*)(ws + WS_X1), xin, modl + 2 * D, D, 6 * D, T / 256};
      PH(6, pg8::gemm_phase<pg8::EpiResid, pg8::StaticOrder, true, true>(c.lds, g, S, E, c.wave)); }
    xcd_barrier(bar);
    norm_mod_phase<false, L == 1>(p, c, (const float*)(ws + WS_X1), p.in[Q + 7], L, 3 * D, hb, L ? p.in[43] : nullptr);
    xcd_barrier(bar);
    if (L == 0) {
        { pg8::Gemm g{hb, (const bf16*)(ws + WS_FGU), M, 2 * FF, D}; pg8::StaticOrder S; S.init(M, 2 * FF, NWG, c.wg);
          pg8::EpiSwiglu E{(bf16*)(ws + WS_REG + FX_ACT), FF, NFT};
          PH(8, pg8::gemm_phase<pg8::EpiSwiglu, pg8::StaticOrder, true, true>(c.lds, g, S, E, c.wave)); }
        xcd_barrier(bar);
        { pg8::Gemm g{(const bf16*)(ws + WS_REG + FX_ACT), (const bf16*)(ws + WS_FD), M, D, FF}; pg8::StaticOrder S; S.init(M, D, NWG, c.wg);
          pg8::EpiResid E{(float*)(ws + WS_X2), (const float*)(ws + WS_X1), modl + 5 * D, D, 6 * D, T / 256};
          PH(9, pg8::gemm_phase<pg8::EpiResid, pg8::StaticOrder, true, true>(c.lds, g, S, E, c.wave)); }
        xcd_barrier(bar);
    } else {
        PH(7, moe_gather_phase(p, c));
        xcd_barrier(bar);
        const LAS int* tb = (const LAS int*)(c.lds + LDSCTL_OFF + 64);
        { pg8::Gemm g{(const bf16*)(ws + WS_REG + FX_AMOE), (const bf16*)(ws + WS_EGU), SLOTS, NE * 2 * FF, D / 2}; pg8::MoeOrder S{tb, NFT, NWG, c.wg};
          pg8::EpiSwigluF8 E{ws + WS_REG + FX_ACT, FF, NFT, 1.0f / (A8_SCALE * W8_SCALE), H8_SCALE};
          PH(8, pg8::gemm_phase<pg8::EpiSwigluF8, pg8::MoeOrder, true, true, true>(c.lds, g, S, E, c.wave)); }
        xcd_barrier(bar);
        { pg8::Gemm g{(const bf16*)(ws + WS_REG + FX_ACT), (const bf16*)(ws + WS_ED), SLOTS, NE * D, FF / 2}; pg8::MoeOrder S{tb, D / 256, NWG, c.wg};
          pg8::EpiStoreBf16S E{(bf16*)(ws + WS_REG + FX_OSLOT), D, D / 256, 1.0f / (H8_SCALE * W8_SCALE)};
          PH(9, pg8::gemm_phase<pg8::EpiStoreBf16S, pg8::MoeOrder, true, true, true>(c.lds, g, S, E, c.wave)); }
        xcd_barrier(bar);
        PH(10, final_phase(p, c));
    }
}

__global__ void __launch_bounds__(512, 2) fwd_kernel(Params p) {
    extern __shared__ __attribute__((aligned(16))) unsigned char lds_raw[];
    Ctx c; c.lds = (LAS unsigned char*)lds_raw; c.wave = __builtin_amdgcn_readfirstlane((int)threadIdx.x >> 6); asm volatile("v_mbcnt_lo_u32_b32 %0, -1, 0\n\tv_mbcnt_hi_u32_b32 %0, -1, %0" : "=v"(c.lane)); c.tid = c.wave * 64 + c.lane; c.wg = blockIdx.x;
    for (int u = c.tid; u < (LDS_BYTES - LDSCTL_OFF) / 4; u += 512) ((LAS unsigned*)(c.lds + LDSCTL_OFF))[u] = 0u;
    __syncthreads();
    const XcdBarrier bar = xcd_barrier_post((unsigned*)(p.ws + WS_CTL) + CW_BAR, (volatile LAS unsigned*)(c.lds + LDSCTL_OFF));
    PH(0, p0_prologue(p, c));
    xcd_barrier(bar);
    layer_phases<0>(p, c, bar, p.in[0]);
    layer_phases<1>(p, c, bar, (const float*)(p.ws + WS_X2));
}
}

extern "C" void kernel_launch(void* const* d_in, const int* in_sizes, int n_in, void* d_out, int out_size, void* d_ws, size_t ws_size, hipStream_t stream) {
    if (n_in != 48 || out_size != M * D || ws_size < WS_END) { fprintf(stderr, "kernel_launch: unexpected problem (n_in %d out %d ws %zu need %zu)\n", n_in, out_size, ws_size, (size_t)WS_END); return; }
    static int ready = 0;
    if (!ready) {
        if (hipFuncSetAttribute((const void*)fwd_kernel, hipFuncAttributeMaxDynamicSharedMemorySize, LDS_BYTES) != hipSuccess) { fprintf(stderr, "kernel_launch: hipFuncSetAttribute failed\n"); return; }
        int per_cu = 0, dev = 0, cus = 0;
        (void)hipGetDevice(&dev); (void)hipDeviceGetAttribute(&cus, hipDeviceAttributeMultiprocessorCount, dev);
        if (hipOccupancyMaxActiveBlocksPerMultiprocessor(&per_cu, (const void*)fwd_kernel, 512, LDS_BYTES) != hipSuccess || per_cu < 1 || cus < NWG) { fprintf(stderr, "kernel_launch: grid of %d workgroups is not resident (per_cu %d, cus %d)\n", NWG, per_cu, cus); return; }
        ready = 1;
    }
    (void)hipMemsetAsync((char*)d_ws + WS_CTL, 0, CTL_BYTES, stream);
    Params p; memset(&p, 0, sizeof(p));
    for (int i = 0; i < 48; ++i) p.in[i] = (const float*)d_in[i];
    p.out = (float*)d_out; p.ws = (unsigned char*)d_ws;
    hipLaunchKernelGGL(fwd_kernel, dim3(NWG), dim3(512), LDS_BYTES, stream, p);
}
```

```cpp
#include <hip/hip_runtime.h>
#include <stdint.h>
#include <string.h>
#include <stdio.h>
namespace pg8 {
#define PG8_LAS __attribute__((address_space(3)))
typedef unsigned short bf16_t;
typedef short bf16x8 __attribute__((ext_vector_type(8)));
typedef float f32x4 __attribute__((ext_vector_type(4)));
typedef unsigned u32x4 __attribute__((ext_vector_type(4)));
constexpr int BM = 256, BK = 64, HALF = 128, HTB = HALF * BK * 2  , STAGE_BYTES = 8 * HTB, NXCD = 8, WGM = 8;

__host__ __device__ __forceinline__ int lds_byte(int r, int c) { const int st = (r >> 4) * 2 + (c >> 5), rr = r & 15, cc = c & 31, ob = rr * 64 + cc * 2; return st * 1024 + (ob ^ (((ob >> 9) & 1) << 5)); }
__host__ __device__ __forceinline__ void stage_rc(int b, int& R, int& C) { const int st = b / 1024, sb = b % 1024, swz = sb ^ (((sb >> 9) & 1) << 5); R = (st >> 1) * 16 + swz / 64; C = (st & 1) * 32 + (swz % 64) / 2; }
__host__ __device__ __forceinline__ int perm32(int rho) { const int n = rho >> 4, i = rho & 15; return 8 * (i >> 2) + 4 * n + (i & 3); }

struct Unit { int pm, pn; };
struct Gemm { const bf16_t* A; const bf16_t* Bt; int M, N, K; };

struct StaticOrder {
    int nM, nN, nwg, G, c;
    __host__ __device__ void init(int M, int N, int G_, int c_) { nM = M / BM; nN = N / BM; nwg = nM * nN; G = G_; c = c_; }
    __host__ __device__ bool next(int i, Unit& u) const {
        const long L = (long)i * G + c; if (L >= nwg) return false;
        int wgid = (int)L; { const int q = nwg / NXCD, r = nwg % NXCD, xcd = wgid % NXCD, off = wgid / NXCD; wgid = (xcd < r ? xcd * (q + 1) : r * (q + 1) + (xcd - r) * q) + off; }
        const int nig = WGM * nN, gid = wgid / nig, fm = gid * WGM, gsz = (nM - fm) < WGM ? (nM - fm) : WGM;
        u.pm = fm + ((wgid % nig) % gsz); u.pn = (wgid % nig) / gsz; return true;
    }
    __device__ __forceinline__ void a_ready(const Unit&) const {}
    __device__ __forceinline__ void done(const Unit&) const {}
};

typedef float f32x2cv_ __attribute__((ext_vector_type(2))); typedef __bf16 bf16x2cv_ __attribute__((ext_vector_type(2)));
__device__ __forceinline__ unsigned cvt_pk_bf16(float lo, float hi) { const f32x2cv_ v = {lo, hi}; const bf16x2cv_ b = __builtin_convertvector(v, bf16x2cv_); return __builtin_bit_cast(unsigned, b); }

__device__ __forceinline__ float silu_f(float x) { return x * __builtin_amdgcn_rcpf(1.0f + __expf(-x)); }
struct EpiStoreBf16 {
    static constexpr bool PERM = true, AFTER_DRAIN = false;
    bf16_t* O; int ldc;
    __device__ __forceinline__ void operator()(const f32x4 (&acc)[2][2][4][2], const Unit& u, int wr, int wc, int fr, int fq) const {
        const int row0 = u.pm * BM + wr * 64 + fr, col0 = u.pn * BM + wc * 32 + 8 * fq;
#pragma unroll
        for (int ai = 0; ai < 2; ++ai)
#pragma unroll
            for (int m = 0; m < 4; ++m) { bf16_t* rowp = O + (size_t)(row0 + ai * HALF + m * 16) * ldc + col0;
#pragma unroll
                for (int bj = 0; bj < 2; ++bj) { const f32x4 v0 = acc[ai][bj][m][0], v1 = acc[ai][bj][m][1];
                    u32x4 w; w.x = cvt_pk_bf16(v0[0], v0[1]); w.y = cvt_pk_bf16(v0[2], v0[3]); w.z = cvt_pk_bf16(v1[0], v1[1]); w.w = cvt_pk_bf16(v1[2], v1[3]);
                    *(u32x4*)(rowp + bj * HALF) = w; } }
    }
};
struct EpiResid {
    static constexpr bool PERM = false, AFTER_DRAIN = false;
    float* C; const float* R; const float* gate; int ldc, gstride, tiles_per_batch;
    __device__ __forceinline__ void operator()(const f32x4 (&acc)[2][2][4][2], const Unit& u, int wr, int wc, int fr, int fq) const {
        const int row0 = u.pm * BM + wr * 64 + fr, col0 = u.pn * BM + wc * 32 + 4 * fq;
        const float* gp = gate + (size_t)(u.pm / tiles_per_batch) * gstride + col0;
        f32x4 gv[2][2];
#pragma unroll
        for (int bj = 0; bj < 2; ++bj)
#pragma unroll
            for (int n = 0; n < 2; ++n) gv[bj][n] = *(const f32x4*)(gp + bj * HALF + n * 16);
#pragma unroll
        for (int ai = 0; ai < 2; ++ai)
#pragma unroll
            for (int m = 0; m < 4; ++m) { const size_t off = (size_t)(row0 + ai * HALF + m * 16) * ldc + col0;
#pragma unroll
                for (int bj = 0; bj < 2; ++bj)
#pragma unroll
                    for (int n = 0; n < 2; ++n) { const f32x4 r = *(const f32x4*)(R + off + bj * HALF + n * 16); *(f32x4*)(C + off + bj * HALF + n * 16) = r + gv[bj][n] * acc[ai][bj][m][n]; } }
    }
};
struct EpiSwiglu {
    static constexpr bool PERM = true, AFTER_DRAIN = false;
    bf16_t* O; int ldc, nN;
    __device__ __forceinline__ void operator()(const f32x4 (&acc)[2][2][4][2], const Unit& u, int wr, int wc, int fr, int fq) const {
        const int row0 = u.pm * BM + wr * 64 + fr, col0 = (u.pn % nN) * HALF + wc * 32 + 8 * fq;
#pragma unroll
        for (int ai = 0; ai < 2; ++ai)
#pragma unroll
            for (int m = 0; m < 4; ++m) {
                const f32x4 g0 = acc[ai][0][m][0], g1 = acc[ai][0][m][1], u0 = acc[ai][1][m][0], u1 = acc[ai][1][m][1];
                u32x4 w;
                w.x = cvt_pk_bf16(silu_f(g0[0]) * u0[0], silu_f(g0[1]) * u0[1]); w.y = cvt_pk_bf16(silu_f(g0[2]) * u0[2], silu_f(g0[3]) * u0[3]);
                w.z = cvt_pk_bf16(silu_f(g1[0]) * u1[0], silu_f(g1[1]) * u1[1]); w.w = cvt_pk_bf16(silu_f(g1[2]) * u1[2], silu_f(g1[3]) * u1[3]);
                *(u32x4*)(O + (size_t)(row0 + ai * HALF + m * 16) * ldc + col0) = w; }
    }
};
struct EpiStoreF32 {
    static constexpr bool PERM = false, AFTER_DRAIN = false;
    float* C; int ldc, nN;
    __device__ __forceinline__ void operator()(const f32x4 (&acc)[2][2][4][2], const Unit& u, int wr, int wc, int fr, int fq) const {
        const int row0 = u.pm * BM + wr * 64 + fr, col0 = (u.pn % nN) * BM + wc * 32 + 4 * fq;
#pragma unroll
        for (int ai = 0; ai < 2; ++ai)
#pragma unroll
            for (int m = 0; m < 4; ++m) { float* rowp = C + (size_t)(row0 + ai * HALF + m * 16) * ldc + col0;
#pragma unroll
                for (int bj = 0; bj < 2; ++bj)
#pragma unroll
                    for (int n = 0; n < 2; ++n) *(f32x4*)(rowp + bj * HALF + n * 16) = acc[ai][bj][m][n]; }
    }
};
__device__ __forceinline__ unsigned pk4_fp8(float a, float b, float c, float d) { int w = 0; w = __builtin_amdgcn_cvt_pk_fp8_f32(a, b, w, false); w = __builtin_amdgcn_cvt_pk_fp8_f32(c, d, w, true); return (unsigned)w; }
__device__ __forceinline__ float sat8(float x) { return __builtin_amdgcn_fmed3f(x, -448.0f, 448.0f); }
__device__ __forceinline__ unsigned pk4_fp8_sat(float a, float b, float c, float d) { return pk4_fp8(sat8(a), sat8(b), sat8(c), sat8(d)); }
struct EpiSwigluF8 {
    static constexpr bool PERM = true, AFTER_DRAIN = false;
    unsigned char* O; int ldc, nN; float sin, sout;
    __device__ __forceinline__ void operator()(const f32x4 (&acc)[2][2][4][2], const Unit& u, int wr, int wc, int fr, int fq) const {
        const int row0 = u.pm * BM + wr * 64 + fr, col0 = (u.pn % nN) * HALF + wc * 32 + 8 * fq;
        typedef unsigned u32x2_ __attribute__((ext_vector_type(2)));
#pragma unroll
        for (int ai = 0; ai < 2; ++ai)
#pragma unroll
            for (int m = 0; m < 4; ++m) {
                const f32x4 g0 = acc[ai][0][m][0] * sin, g1 = acc[ai][0][m][1] * sin, u0 = acc[ai][1][m][0] * (sin * sout), u1 = acc[ai][1][m][1] * (sin * sout);
                u32x2_ w;
                w.x = pk4_fp8_sat(silu_f(g0[0]) * u0[0], silu_f(g0[1]) * u0[1], silu_f(g0[2]) * u0[2], silu_f(g0[3]) * u0[3]);
                w.y = pk4_fp8_sat(silu_f(g1[0]) * u1[0], silu_f(g1[1]) * u1[1], silu_f(g1[2]) * u1[2], silu_f(g1[3]) * u1[3]);
                *(u32x2_*)(O + (size_t)(row0 + ai * HALF + m * 16) * ldc + col0) = w; }
    }
};
struct EpiStoreF32S {
    static constexpr bool PERM = false, AFTER_DRAIN = false;
    float* C; int ldc, nN; float s;
    __device__ __forceinline__ void operator()(const f32x4 (&acc)[2][2][4][2], const Unit& u, int wr, int wc, int fr, int fq) const {
        const int row0 = u.pm * BM + wr * 64 + fr, col0 = (u.pn % nN) * BM + wc * 32 + 4 * fq;
#pragma unroll
        for (int ai = 0; ai < 2; ++ai)
#pragma unroll
            for (int m = 0; m < 4; ++m) { float* rowp = C + (size_t)(row0 + ai * HALF + m * 16) * ldc + col0;
#pragma unroll
                for (int bj = 0; bj < 2; ++bj)
#pragma unroll
                    for (int n = 0; n < 2; ++n) *(f32x4*)(rowp + bj * HALF + n * 16) = acc[ai][bj][m][n] * s; }
    }
};
struct EpiStoreBf16S {
    static constexpr bool PERM = true, AFTER_DRAIN = false;
    bf16_t* O; int ldc, nN; float s;
    __device__ __forceinline__ void operator()(const f32x4 (&acc)[2][2][4][2], const Unit& u, int wr, int wc, int fr, int fq) const {
        const int row0 = u.pm * BM + wr * 64 + fr, col0 = (u.pn % nN) * BM + wc * 32 + 8 * fq;
#pragma unroll
        for (int ai = 0; ai < 2; ++ai)
#pragma unroll
            for (int m = 0; m < 4; ++m) { bf16_t* rowp = O + (size_t)(row0 + ai * HALF + m * 16) * ldc + col0;
#pragma unroll
                for (int bj = 0; bj < 2; ++bj) { const f32x4 v0 = acc[ai][bj][m][0] * s, v1 = acc[ai][bj][m][1] * s;
                    u32x4 w; w.x = cvt_pk_bf16(v0[0], v0[1]); w.y = cvt_pk_bf16(v0[2], v0[3]); w.z = cvt_pk_bf16(v1[0], v1[1]); w.w = cvt_pk_bf16(v1[2], v1[3]);
                    *(u32x4*)(rowp + bj * HALF) = w; } }
    }
};
struct MoeOrder {
    const PG8_LAS int* tb; int nN, G, c;
    __device__ __forceinline__ bool next(int i, Unit& u) const {
        const int L = i * G + c; if (L >= tb[8] * nN) return false;
        int e = 0;
#pragma unroll
        for (int q = 1; q < 8; ++q) if (L >= tb[q] * nN) e = q;
        const int t0 = tb[e], rt = tb[e + 1] - t0, idx = L - t0 * nN;
        u.pm = t0 + idx % rt; u.pn = e * nN + idx / rt; return true;
    }
    __device__ __forceinline__ void a_ready(const Unit&) const {}
    __device__ __forceinline__ void done(const Unit&) const {}
};


template <class Epi, class Sched, bool ALIGN_EPI = false, bool SP2 = false, bool FP8 = false>
__device__ __forceinline__ void gemm_phase(PG8_LAS unsigned char* lds, const Gemm g, const Sched& S, const Epi& E, const int wave_id) {
    int lane_; asm volatile("v_mbcnt_lo_u32_b32 %0, -1, 0\n\tv_mbcnt_hi_u32_b32 %0, -1, %0" : "=v"(lane_));
    const int wid = wave_id, lane = lane_, tid = wid * 64 + lane, wr = wid >> 2, wc = wid & 3, fr = lane & 15, fq = lane >> 4;
    const int K = g.K, nt = K / BK;
    unsigned voffA[2], voffB[2];
#pragma unroll
    for (int i = 0; i < 2; ++i) { int R, C; stage_rc(tid * 16 + i * 8192, R, C); const int Rb = Epi::PERM ? ((R & ~31) + perm32(R & 31)) : R;
        voffA[i] = (unsigned)(R * K + C) * 2u; voffB[i] = (unsigned)(Rb * K + C) * 2u; }
    const size_t kstep = (size_t)(BK * 2);
    const size_t hstep = (size_t)HALF * K * 2;
    const size_t tstep = 2 * hstep;
    const unsigned ldsw = (unsigned)wid * 1024u;
    const int aoff = lds_byte(wr * 64 + fr, fq * 8), boff = lds_byte(wc * 32 + fr, fq * 8);
#define PG8_SA(b, h) (((b) * 2 + (h)) * HTB)
#define PG8_SB(b, h) ((4 + (b) * 2 + (h)) * HTB)
#define PG8_STAGE(bufoff, gbase, voff) do { _Pragma("unroll") for (int _i = 0; _i < 2; ++_i) \
        __builtin_amdgcn_global_load_lds((const unsigned*)((const char*)(gbase) + (voff)[_i]), (PG8_LAS unsigned*)(lds + (bufoff) + ldsw + _i * 8192), 16, 0, 0); } while (0)
#define PG8_LDA(dst, b, h) do { _Pragma("unroll") for (int m = 0; m < 4; ++m) _Pragma("unroll") for (int k = 0; k < 2; ++k) dst[m][k] = *(const PG8_LAS bf16x8*)(lds + PG8_SA(b, h) + aoff + m * 2048 + k * 1024); } while (0)
#define PG8_LDB(dst, b, h) do { _Pragma("unroll") for (int n = 0; n < 2; ++n) _Pragma("unroll") for (int k = 0; k < 2; ++k) dst[n][k] = *(const PG8_LAS bf16x8*)(lds + PG8_SB(b, h) + boff + n * 2048 + k * 1024); } while (0)
#define PG8_MMA(ai, bj, At, Bt) do { __builtin_amdgcn_s_setprio(1); _Pragma("unroll") for (int m = 0; m < 4; ++m) _Pragma("unroll") for (int n = 0; n < 2; ++n) { \
        if constexpr (FP8) { typedef int i32x4_ __attribute__((ext_vector_type(4))); typedef int i32x8_ __attribute__((ext_vector_type(8))); \
            const i32x8_ b8_ = __builtin_shufflevector(__builtin_bit_cast(i32x4_, Bt[n][0]), __builtin_bit_cast(i32x4_, Bt[n][1]), 0, 1, 2, 3, 4, 5, 6, 7); \
            const i32x8_ a8_ = __builtin_shufflevector(__builtin_bit_cast(i32x4_, At[m][0]), __builtin_bit_cast(i32x4_, At[m][1]), 0, 1, 2, 3, 4, 5, 6, 7); \
            asm volatile("v_mfma_scale_f32_16x16x128_f8f6f4 %0, %1, %2, %0, %3, %3 op_sel_hi:[0,0,0]" : "+v"(acc[ai][bj][m][n]) : "v"(b8_), "v"(a8_), "v"(one8_)); } \
        else { _Pragma("unroll") for (int k = 0; k < 2; ++k) acc[ai][bj][m][n] = __builtin_amdgcn_mfma_f32_16x16x32_bf16(Bt[n][k], At[m][k], acc[ai][bj][m][n], 0, 0, 0); } } \
        __builtin_amdgcn_s_setprio(0); } while (0)
#define PG8_WAIT_V(n) asm volatile("s_waitcnt vmcnt(" #n ")" ::: "memory")
#define PG8_WAIT_L(n) asm volatile("s_waitcnt lgkmcnt(" #n ")" ::: "memory")
#define PG8_BAR __builtin_amdgcn_s_barrier()
#define PG8_SCHED __builtin_amdgcn_sched_barrier(0)
    const int one8_ = 0x7F7F7F7F;
    Unit cur, nxt; int ui = 0;
    if (!S.next(0, cur)) return;
    f32x4 acc[2][2][4][2];
#pragma unroll
    for (int a = 0; a < 2; ++a)
#pragma unroll
        for (int b = 0; b < 2; ++b)
#pragma unroll
            for (int m = 0; m < 4; ++m)
#pragma unroll
                for (int n = 0; n < 2; ++n) acc[a][b][m][n] = (f32x4){0.f, 0.f, 0.f, 0.f};
    bf16x8 At[4][2], B0[2][2], B1[2][2];
    const char* cA = (const char*)g.A + (size_t)cur.pm * tstep; const char* cB = (const char*)g.Bt + (size_t)cur.pn * tstep;
    S.a_ready(cur);
    if constexpr (SP2) {
        PG8_STAGE(PG8_SB(0, 0), cB, voffB); PG8_STAGE(PG8_SB(0, 1), cB + hstep, voffB); PG8_STAGE(PG8_SA(0, 0), cA, voffA); PG8_STAGE(PG8_SA(0, 1), cA + hstep, voffA);
        if (wr == 1) PG8_BAR;
        PG8_WAIT_V(2); PG8_BAR;
        PG8_STAGE(PG8_SB(1, 0), cB + kstep, voffB); PG8_STAGE(PG8_SA(1, 0), cA + kstep, voffA); PG8_STAGE(PG8_SB(1, 1), cB + hstep + kstep, voffB);
        PG8_WAIT_V(6); PG8_BAR;
    } else {
        PG8_STAGE(PG8_SB(0, 0), cB, voffB); PG8_STAGE(PG8_SA(0, 0), cA, voffA); PG8_STAGE(PG8_SB(0, 1), cB + hstep, voffB); PG8_STAGE(PG8_SA(0, 1), cA + hstep, voffA);
        if (wr == 1) PG8_BAR;
        PG8_WAIT_V(4); PG8_BAR;
        PG8_STAGE(PG8_SB(1, 0), cB + kstep, voffB); PG8_STAGE(PG8_SA(1, 0), cA + kstep, voffA); PG8_STAGE(PG8_SB(1, 1), cB + hstep + kstep, voffB);
        PG8_WAIT_V(6); PG8_BAR;
    }
    for (;;) {
        const bool has_next = S.next(ui + 1, nxt);
        const char* nA = has_next ? (const char*)g.A + (size_t)nxt.pm * tstep : cA; const char* nB = has_next ? (const char*)g.Bt + (size_t)nxt.pn * tstep : cB;
        for (int t = 0; t < nt; t += 2) {
            const bool last = (t == nt - 2);
            const char* a1 = cA + (size_t)(t + 1) * kstep;
            const char* a2 = last ? nA : cA + (size_t)(t + 2) * kstep; const char* b2 = last ? nB : cB + (size_t)(t + 2) * kstep;
            const char* a3 = a2 + kstep; const char* b3 = b2 + kstep;
            if (last && has_next) S.a_ready(nxt);
            if constexpr (SP2) {
            PG8_LDB(B0, 0, 0); PG8_LDB(B1, 0, 1); PG8_SCHED; PG8_LDA(At, 0, 0); PG8_STAGE(PG8_SA(1, 1), a1 + hstep, voffA);
            PG8_WAIT_V(8); PG8_WAIT_L(0); PG8_BAR; PG8_MMA(0, 0, At, B0); PG8_MMA(0, 1, At, B1); PG8_BAR; PG8_SCHED;
            PG8_LDA(At, 0, 1); PG8_STAGE(PG8_SB(0, 0), b2, voffB); PG8_STAGE(PG8_SB(0, 1), b2 + hstep, voffB); PG8_STAGE(PG8_SA(0, 0), a2, voffA);
            PG8_WAIT_V(8); PG8_WAIT_L(0); PG8_BAR; PG8_MMA(1, 0, At, B0); PG8_MMA(1, 1, At, B1); PG8_BAR; PG8_SCHED;
            PG8_LDB(B0, 1, 0); PG8_LDB(B1, 1, 1); PG8_SCHED; PG8_LDA(At, 1, 0); PG8_STAGE(PG8_SA(0, 1), a2 + hstep, voffA);
            PG8_WAIT_V(8); PG8_WAIT_L(0); PG8_BAR; PG8_MMA(0, 0, At, B0); PG8_MMA(0, 1, At, B1); PG8_BAR; PG8_SCHED;
            PG8_LDA(At, 1, 1); PG8_STAGE(PG8_SB(1, 0), b3, voffB); PG8_STAGE(PG8_SB(1, 1), b3 + hstep, voffB); PG8_STAGE(PG8_SA(1, 0), a3, voffA);
            PG8_WAIT_V(8); PG8_WAIT_L(0); PG8_BAR; PG8_MMA(1, 0, At, B0); PG8_MMA(1, 1, At, B1); PG8_BAR; PG8_SCHED;
            } else {
            PG8_LDB(B0, 0, 0); PG8_SCHED; PG8_LDA(At, 0, 0); PG8_STAGE(PG8_SA(1, 1), a1 + hstep, voffA);
            PG8_WAIT_L(8); PG8_BAR; PG8_WAIT_L(0); PG8_MMA(0, 0, At, B0); PG8_BAR; PG8_SCHED;
            PG8_LDB(B1, 0, 1); PG8_STAGE(PG8_SB(0, 0), b2, voffB);
            PG8_BAR; PG8_WAIT_L(0); PG8_MMA(0, 1, At, B1); PG8_BAR;
            PG8_LDA(At, 0, 1); PG8_STAGE(PG8_SA(0, 0), a2, voffA);
            PG8_BAR; PG8_WAIT_L(0); PG8_MMA(1, 0, At, B0); PG8_BAR; PG8_SCHED;
            PG8_STAGE(PG8_SB(0, 1), b2 + hstep, voffB);
            PG8_WAIT_V(6); PG8_BAR; PG8_MMA(1, 1, At, B1); PG8_BAR;
            PG8_LDB(B0, 1, 0); PG8_SCHED; PG8_LDA(At, 1, 0); PG8_STAGE(PG8_SA(0, 1), a2 + hstep, voffA);
            PG8_WAIT_L(8); PG8_BAR; PG8_WAIT_L(0); PG8_MMA(0, 0, At, B0); PG8_BAR; PG8_SCHED;
            PG8_LDB(B1, 1, 1); PG8_STAGE(PG8_SB(1, 0), b3, voffB);
            PG8_BAR; PG8_WAIT_L(0); PG8_MMA(0, 1, At, B1); PG8_BAR;
            PG8_LDA(At, 1, 1); PG8_STAGE(PG8_SA(1, 0), a3, voffA);
            PG8_BAR; PG8_WAIT_L(0); PG8_MMA(1, 0, At, B0); PG8_BAR; PG8_SCHED;
            PG8_STAGE(PG8_SB(1, 1), b3 + hstep, voffB);
            PG8_WAIT_V(6); PG8_BAR; PG8_MMA(1, 1, At, B1); PG8_BAR;
            }
        }
        if constexpr (FP8) asm volatile("s_nop 15\n\ts_nop 15" ::: "memory");
        if constexpr (ALIGN_EPI) { if (wr == 0) PG8_BAR; }
        if constexpr (!Epi::AFTER_DRAIN) { E(acc, cur, wr, wc, fr, fq); S.done(cur); }
        if (!has_next) break;
#pragma unroll
        for (int a = 0; a < 2; ++a)
#pragma unroll
            for (int b = 0; b < 2; ++b)
#pragma unroll
                for (int m = 0; m < 4; ++m)
#pragma unroll
                    for (int n = 0; n < 2; ++n) acc[a][b][m][n] = (f32x4){0.f, 0.f, 0.f, 0.f};
        cur = nxt; cA = nA; cB = nB; ++ui;
        if constexpr (ALIGN_EPI) { if (wr == 1) PG8_BAR; }
    }
    PG8_WAIT_V(0);
    if constexpr (!ALIGN_EPI) { if (wr == 0) PG8_BAR; }
    PG8_BAR;
    if constexpr (Epi::AFTER_DRAIN) { E.fused(acc, cur, wr, wc, fr, fq, lds, wid, lane); S.done(cur); }
#undef PG8_SA
#undef PG8_SB
#undef PG8_STAGE
#undef PG8_LDA
#undef PG8_LDB
#undef PG8_MMA
#undef PG8_WAIT_V
#undef PG8_WAIT_L
#undef PG8_BAR
#undef PG8_SCHED
}
}

#define LAS __attribute__((address_space(3)))
#define XB_TMO      128
#define XB_XCNT(j)  (256  + 64 * (j))
#define XB_XSUB(j)  (1280 + 64 * (j))
#define XB_XGEN(j)  (2304 + 64 * (j))
#define XB_TOP      3328
#define XB_TOPGEN   3392
#define XCD_BAR_WORDS 3456
#define XB_SPIN_CAP (1u << 18)

__device__ __forceinline__ unsigned xb_ld(unsigned* p)              { return __hip_atomic_load(p, __ATOMIC_RELAXED, __HIP_MEMORY_SCOPE_AGENT); }
__device__ __forceinline__ unsigned xb_add(unsigned* p, unsigned v) { return __hip_atomic_fetch_add(p, v, __ATOMIC_RELAXED, __HIP_MEMORY_SCOPE_AGENT); }
__device__ __forceinline__ unsigned xb_xcc_id() { return (unsigned)__builtin_amdgcn_s_getreg((3 << 11) | 20) & 0xFu; }
#define XB_SPIN(cond, bar) do { unsigned _sp = 0; while (cond) { __builtin_amdgcn_s_sleep(1); \
    if ((++_sp & 255u) == 0u) { if (xb_ld(&(bar)[XB_TMO])) break; if (_sp > XB_SPIN_CAP) { atomicAdd(&(bar)[XB_TMO], 1u); break; } } } } while (0)

struct XcdBarrier {
    unsigned* bar; unsigned x;
    volatile LAS unsigned* st;
};

__device__ __forceinline__ XcdBarrier xcd_barrier_post(unsigned* bar, volatile LAS unsigned* st) {
    XcdBarrier b; b.bar = bar; b.x = xb_xcc_id(); b.st = st;
    if (threadIdx.x == 0) (void)xb_add(&bar[XB_XCNT(b.x)], 1u);
    return b;
}
__device__ __forceinline__ void xcd_barrier_complete(unsigned* bar, unsigned x, unsigned& nloc, unsigned& nx) {
    const unsigned G = gridDim.x * gridDim.y * gridDim.z;
    unsigned sum, cnt, mine, sp = 0u;
    for (;;) {
        sum = 0u; cnt = 0u; mine = 0u;
#pragma unroll
        for (unsigned j = 0; j < 16; ++j) { const unsigned c = xb_ld(&bar[XB_XCNT(j)]); sum += c; cnt += (c > 0u) ? 1u : 0u; mine = (j == x) ? c : mine; }
        if (sum == G) break;
        __builtin_amdgcn_s_sleep(1);
        if ((++sp & 255u) == 0u) { if (xb_ld(&bar[XB_TMO])) break; if (sp > XB_SPIN_CAP) { atomicAdd(&bar[XB_TMO], 1u); break; } }
    }
    nloc = mine > 0u ? mine : 1u; nx = cnt > 0u ? cnt : 1u;
}

__device__ __forceinline__ void xcd_barrier(const XcdBarrier& b) {
    asm volatile("s_waitcnt vmcnt(0)" ::: "memory");
    __syncthreads();
    if (threadIdx.x == 0) {
        unsigned* bar = b.bar;
        __builtin_amdgcn_s_waitcnt(0);
        unsigned nloc = b.st[0], nx = b.st[1];
        if (nloc == 0u) { xcd_barrier_complete(bar, b.x, nloc, nx); b.st[0] = nloc; b.st[1] = nx; }
        const unsigned old = xb_add(&bar[XB_XSUB(b.x)], 1u);
        const unsigned gen = old / nloc;
        if (old + 1u == (gen + 1u) * nloc) {
            __builtin_amdgcn_fence(__ATOMIC_RELEASE, "agent");
            asm volatile("s_waitcnt vmcnt(0)" ::: "memory");
            const unsigned og = xb_add(&bar[XB_TOP], 1u);
            const unsigned tg = og / nx;
            if (og + 1u == (tg + 1u) * nx) xb_add(&bar[XB_TOPGEN], 1u);
            else XB_SPIN(xb_ld(&bar[XB_TOPGEN]) == tg, bar);
            __builtin_amdgcn_fence(__ATOMIC_ACQUIRE, "agent");
            xb_add(&bar[XB_XGEN(b.x)], 1u);
            asm volatile("s_waitcnt vmcnt(0)" ::: "memory");
        } else {
            XB_SPIN(xb_ld(&bar[XB_XGEN(b.x)]) == gen, bar);
            __builtin_amdgcn_fence(__ATOMIC_ACQUIRE, "agent");
            asm volatile("s_waitcnt vmcnt(0)" ::: "memory");
        }
    }
    __syncthreads();
}

#ifndef REP_PHASE
#define REP_PHASE -1
#endif
#ifndef REP_N
#define REP_N 1
#endif
#define PH(k, ...) do { __VA_ARGS__; if (REP_PHASE == (k)) { for (int rn_ = 0; rn_ < REP_N; ++rn_) { xcd_barrier(bar); __VA_ARGS__; } } } while (0)
namespace {
typedef unsigned short bf16;
typedef float f32x4 __attribute__((ext_vector_type(4)));
typedef float f32x2 __attribute__((ext_vector_type(2)));
typedef unsigned u32x4 __attribute__((ext_vector_type(4)));
typedef unsigned u32x2 __attribute__((ext_vector_type(2)));
typedef short bf16x8 __attribute__((ext_vector_type(8)));
constexpr int D = 2048, NB = 4, T = 2048, M = NB * T, C = 1024, H = 16, HN = 64;
constexpr int NR0 = 3360, NR1 = 3392, NP0 = NR0 + 3072, NP1 = NR1 + 3072, NPP = 6656;
constexpr int MH = 8, MD = 128, MBS = 256, NBLK = 8;
constexpr int FF = 5632, NE = 8, NFT = FF / 128;
constexpr int SLOTS = 2 * M + NE * 256;
constexpr int NWG = 256, NWAVE = 8, NGW = NWG * NWAVE;
constexpr int KSPLIT = 8;
constexpr int RING_BYTES = 131072, LDSCTL_OFF = RING_BYTES, LDS_BYTES = RING_BYTES + 1024;
constexpr size_t al(size_t x) { return (x + 4095) / 4096 * 4096; }
constexpr size_t WS_CTL = 0, CTL_BYTES = 1u << 20;
constexpr int CW_BAR = 1024, CW_CNT = 8192;
constexpr size_t WS_MODP = WS_CTL + CTL_BYTES;
constexpr size_t WS_MOD = WS_MODP + al((size_t)KSPLIT * 2 * NB * 6 * D * 4);
constexpr size_t WS_TOKE = WS_MOD + al((size_t)2 * NB * 6 * D * 4);
constexpr size_t WS_TOKP = WS_TOKE + al((size_t)2 * M * 4);
constexpr size_t WS_TOKW = WS_TOKP + al((size_t)2 * M * 4);
constexpr size_t WS_TOKS = WS_TOKW + al((size_t)2 * M * 4);
constexpr size_t WS_KMEAN = WS_TOKS + al((size_t)2 * M * 4);
constexpr size_t WS_RKB = WS_KMEAN + al((size_t)NB * MH * NBLK * MD * 4);
constexpr size_t WS_LW = WS_RKB + al((size_t)M * H * 4);
constexpr size_t WS_WIN = WS_LW + al((size_t)2 * C * 320 * 2);
constexpr size_t WS_WOUT = WS_WIN + al((size_t)2 * NPP * D * 2);
constexpr size_t WS_FGU = WS_WOUT + al((size_t)2 * D * D * 2);
constexpr size_t WS_FD = WS_FGU + al((size_t)2 * FF * D * 2);
constexpr size_t WS_EGU = WS_FD + al((size_t)D * FF * 2);
constexpr size_t WS_ED = WS_EGU + al((size_t)NE * 2 * FF * D * 2);
constexpr size_t WS_H = WS_ED + al((size_t)NE * D * FF * 2);
constexpr size_t WS_X1 = WS_H + al((size_t)M * D * 2);
constexpr size_t WS_X2 = WS_X1 + al((size_t)M * D * 4);
constexpr size_t WS_VF = WS_X2 + al((size_t)M * D * 4);
constexpr size_t WS_CAT = WS_VF + al((size_t)M * C * 4);
constexpr size_t WS_REG = WS_CAT + al((size_t)M * D * 2);
constexpr size_t MX_PROJ = 0;
constexpr size_t MX_SR = MX_PROJ + al((size_t)M * NPP * 2);
constexpr size_t SARR = al((size_t)M * C * 4);
constexpr size_t MX_SIN = MX_SR;
constexpr size_t MX_SV = MX_SIN + al((size_t)M * H * 320 * 4), MX_SG = MX_SV + SARR, MX_SY = MX_SG + SARR, MX_VT = MX_SY + SARR, MX_END = MX_VT + al((size_t)M * C * 2);
constexpr size_t FX_ACT = 0;
constexpr size_t FX_AMOE = FX_ACT + al((size_t)SLOTS * FF * 2);
constexpr size_t FX_OSLOT = FX_AMOE + al((size_t)SLOTS * D * 2);
constexpr size_t FX_END = FX_OSLOT + al((size_t)SLOTS * D * 4);
constexpr size_t WS_END = WS_REG + (MX_END > FX_END ? MX_END : FX_END);

struct Params { const float* in[48]; float* out; unsigned char* ws; };

template <int CTRL> __device__ __forceinline__ float dpp_mov(float v) { return __int_as_float(__builtin_amdgcn_update_dpp(0, __float_as_int(v), CTRL, 0xF, 0xF, true)); }
__device__ __forceinline__ float row16_sum(float v) {
    v += dpp_mov<0xB1>(v);
    v += dpp_mov<0x4E>(v);
    v += dpp_mov<0x141>(v);
    v += dpp_mov<0x140>(v);
    return v;
}
__device__ __forceinline__ float xor_lane(float v, int lane, int m) { return __int_as_float(__builtin_amdgcn_ds_bpermute((lane ^ m) << 2, __float_as_int(v))); }
__device__ __forceinline__ float wave_sum(float v, int lane) { v = row16_sum(v); v += xor_lane(v, lane, 16); v += xor_lane(v, lane, 32); return v; }
__device__ __forceinline__ float bf2f(bf16 b) { return __uint_as_float(((unsigned)b) << 16); }
__device__ __forceinline__ float bflo(unsigned w) { return __uint_as_float(w << 16); }
__device__ __forceinline__ float bfhi(unsigned w) { return __uint_as_float(w & 0xffff0000u); }
__device__ __forceinline__ unsigned pk_bf16(float lo, float hi) { return pg8::cvt_pk_bf16(lo, hi); }
__device__ __forceinline__ float sigmoid_f(float x) { return 1.0f / (1.0f + __expf(-x)); }
#define LDS_WAIT() asm volatile("s_waitcnt lgkmcnt(0)" ::: "memory")

struct Ctx { LAS unsigned char* lds; int tid, lane, wave, wg; };
__device__ __forceinline__ Ctx fresh_ctx(const Ctx& a) {
    Ctx c; int ln, w = a.wg; asm volatile("v_mbcnt_lo_u32_b32 %0, -1, 0\n\tv_mbcnt_hi_u32_b32 %0, -1, %0" : "=v"(ln)); asm volatile("" : "+v"(w));
    c.lds = a.lds; c.lane = ln; c.wave = a.wave; c.tid = a.wave * 64 + ln; c.wg = __builtin_amdgcn_readfirstlane(w); return c;
}
__device__ __forceinline__ unsigned char* fresh_ws(const struct Params& p);

__device__ __forceinline__ unsigned char* fresh_ws(const Params& p) {
    unsigned z = 0u; asm volatile("" : "+v"(z));
    return p.ws + (size_t)__builtin_amdgcn_readfirstlane(z);
}
__device__ __forceinline__ void p0_mod_item(const Params& p, const Ctx& c, int it, LAS float* scr) {
    const int ks = it % KSPLIT, cg = (it / KSPLIT) % 192, l = it / (KSPLIT * 192);
    const float* cc = p.in[1]; const float* mw = p.in[l ? 23 : 2];
    const int k0 = ks * 256;
#pragma unroll
    for (int b = 0; b < NB; ++b)
#pragma unroll
        for (int i = 0; i < 4; ++i) { const float v = cc[b * D + k0 + c.lane + 64 * i]; scr[(c.lane + 64 * i) * 4 + b] = v / (1.0f + __expf(-v)); }
    LDS_WAIT(); asm volatile("" ::: "memory");
    float a0 = 0.f, a1 = 0.f, a2 = 0.f, a3 = 0.f;
    const float* wp = mw + (size_t)k0 * (6 * D) + cg * 64 + c.lane;
#pragma unroll 16
    for (int k = 0; k < 256; ++k) { const float w = wp[(size_t)k * (6 * D)]; const f32x4 cv = *(const LAS f32x4*)(scr + 4 * k); a0 += cv[0] * w; a1 += cv[1] * w; a2 += cv[2] * w; a3 += cv[3] * w; }
    float* o = (float*)(p.ws + WS_MODP) + ((size_t)(ks * 2 + l) * NB) * (6 * D) + cg * 64 + c.lane;
    o[0] = a0; o[6 * D] = a1; o[2 * 6 * D] = a2; o[3 * 6 * D] = a3;
    LDS_WAIT(); asm volatile("" ::: "memory");
}
struct ConvJob { const float* src; unsigned char* dst; int K, N, kt, nt, dst_row0, f8; };
constexpr float W8_SCALE = 256.0f, A8_SCALE = 16.0f, H8_SCALE = 8.0f;
__device__ __forceinline__ void conv_issue(const ConvJob& j, f32x2 (&cv)[32], int lane) {
    const int n = j.nt * 64 + 2 * (lane & 31); const bool ok = n < j.N;
    const float* s = j.src + (size_t)(j.kt * 64 + 32 * (lane >> 5)) * j.N + (ok ? n : 0);
#pragma unroll
    for (int i = 0; i < 32; ++i) cv[i] = *(const f32x2*)(s + (size_t)i * j.N);
}
__device__ __forceinline__ void conv_finish(const ConvJob& j, f32x2 (&cv)[32], LAS unsigned* scr, int lane) {
    const int n2 = lane & 31, kh = lane >> 5; const bool ok = j.nt * 64 + 2 * n2 < j.N;
    if (j.f8) {
#pragma unroll
        for (int q = 0; q < 2; ++q)
#pragma unroll
            for (int i4 = 0; i4 < 8; ++i4) scr[(2 * n2 + q) * 17 + 8 * kh + i4] = pg8::pk4_fp8(cv[4 * i4][q] * W8_SCALE, cv[4 * i4 + 1][q] * W8_SCALE, cv[4 * i4 + 2][q] * W8_SCALE, cv[4 * i4 + 3][q] * W8_SCALE);
        LDS_WAIT(); asm volatile("" ::: "memory");
        const int cch = lane & 3;
#pragma unroll
        for (int jj = 0; jj < 4; ++jj) { const int nn = (lane >> 2) + 16 * jj; const LAS unsigned* qp = scr + nn * 17 + 4 * cch;
            u32x4 o; o.x = qp[0]; o.y = qp[1]; o.z = qp[2]; o.w = qp[3];
            *(u32x4*)(j.dst + (size_t)(j.dst_row0 + nn) * j.K + j.kt * 64 + 16 * cch) = o; }
    } else {
#pragma unroll
        for (int q = 0; q < 2; ++q)
#pragma unroll
            for (int i2 = 0; i2 < 16; ++i2) scr[(2 * n2 + q) * 33 + 16 * kh + i2] = ok ? pk_bf16(cv[2 * i2][q], cv[2 * i2 + 1][q]) : 0u;
        LDS_WAIT(); asm volatile("" ::: "memory");
        const int cch = lane & 7;
#pragma unroll
        for (int jj = 0; jj < 8; ++jj) { const int nn = (lane >> 3) + 8 * jj; const LAS unsigned* qp = scr + nn * 33 + 4 * cch;
            u32x4 o; o.x = qp[0]; o.y = qp[1]; o.z = qp[2]; o.w = qp[3];
            *(u32x4*)(j.dst + ((size_t)(j.dst_row0 + nn) * j.K + j.kt * 64 + 8 * cch) * 2) = o; }
    }
    LDS_WAIT(); asm volatile("" ::: "memory");
}
__device__ __forceinline__ int gu_row(int n) { return (n >> 7) * 256 + (n & 127); }
constexpr int I_MOD = 2 * 192 * KSPLIT;
constexpr int I_WIN = (NPP / 64) * (D / 64), I_WOUT = (D / 64) * (D / 64), I_FG = (FF / 64) * (D / 64), I_FD = (D / 64) * (FF / 64);
constexpr int BG_DENSE = I_WOUT + 2 * I_FG + I_FD + I_WIN + I_WOUT, BG_TOTAL = BG_DENSE + NE * (2 * I_FG + I_FD);
__device__ __forceinline__ ConvJob bg_job(const Params& p, unsigned char* ws, int r) {
    ConvJob j;
    if (r < I_WOUT) { j.src = p.in[18]; j.dst = ws + WS_WOUT; j.f8 = 0; j.K = D; j.N = D; j.nt = r % (D / 64); j.kt = r / (D / 64); j.dst_row0 = j.nt * 64; return j; } r -= I_WOUT;
    if (r < 2 * I_FG) { const int u = r / I_FG; r -= u * I_FG; j.src = p.in[20 + u]; j.dst = ws + WS_FGU; j.f8 = 0; j.K = D; j.N = FF; j.nt = r % (FF / 64); j.kt = r / (FF / 64); j.dst_row0 = gu_row(j.nt * 64) + u * 128; return j; } r -= 2 * I_FG;
    if (r < I_FD) { j.src = p.in[22]; j.dst = ws + WS_FD; j.f8 = 0; j.K = FF; j.N = D; j.nt = r % (D / 64); j.kt = r / (D / 64); j.dst_row0 = j.nt * 64; return j; } r -= I_FD;
    if (r < I_WIN) { j.src = p.in[26]; j.dst = ws + WS_WIN + (size_t)NPP * D * 2; j.f8 = 0; j.K = D; j.N = NP1; j.nt = r % (NPP / 64); j.kt = r / (NPP / 64); j.dst_row0 = j.nt * 64; return j; } r -= I_WIN;
    if (r < I_WOUT) { j.src = p.in[41]; j.dst = ws + WS_WOUT + (size_t)D * D * 2; j.f8 = 0; j.K = D; j.N = D; j.nt = r % (D / 64); j.kt = r / (D / 64); j.dst_row0 = j.nt * 64; return j; } r -= I_WOUT;
    const int e = r / (2 * I_FG + I_FD); r -= e * (2 * I_FG + I_FD);
    if (r < 2 * I_FG) { const int u = r / I_FG; r -= u * I_FG; j.src = p.in[44 + u] + (size_t)e * D * FF; j.dst = ws + WS_EGU + (size_t)e * 2 * FF * D; j.f8 = 1; j.K = D; j.N = FF; j.nt = r % (FF / 64); j.kt = r / (FF / 64); j.dst_row0 = gu_row(j.nt * 64) + u * 128; return j; } r -= 2 * I_FG;
    j.src = p.in[46] + (size_t)e * FF * D; j.dst = ws + WS_ED + (size_t)e * D * FF; j.f8 = 1; j.K = FF; j.N = D; j.nt = r % (D / 64); j.kt = r / (D / 64); j.dst_row0 = j.nt * 64; return j;
}
__device__ __forceinline__ void p0_prologue(const Params& p, const Ctx& c_) {
    const Ctx c = fresh_ctx(c_);
    LAS unsigned* scr = (LAS unsigned*)(c.lds + c.wave * 16384);
    constexpr int TOTAL = I_MOD + I_WIN;
    unsigned char* ws = fresh_ws(p);
    f32x2 cv[32];
    for (int it = c.wg * NWAVE + c.wave; it < TOTAL; it += NGW) {
        int r = it;
        if (r < I_MOD) { p0_mod_item(p, c, r, (LAS float*)scr); continue; } r -= I_MOD;
        ConvJob j; j.src = p.in[5]; j.dst = ws + WS_WIN; j.f8 = 0; j.K = D; j.N = NP0; j.nt = r % (NPP / 64); j.kt = r / (NPP / 64); j.dst_row0 = j.nt * 64;
        conv_issue(j, cv, c.lane); conv_finish(j, cv, scr, c.lane);
    }
    for (int idx = (c.wg * NWAVE + c.wave) * 64 + c.lane; idx < 2 * 320 * C; idx += NGW * 64) {
        const int l = idx / (320 * C), rem = idx % (320 * C), k = rem / C, col = rem % C;
        const int pb = l ? 23 : 2;
        float v = 0.f;
        if (k < 64) v = p.in[pb + 6][(size_t)k * C + col]; else if (k < 128) v = p.in[pb + 8][(size_t)(k - 64) * C + col]; else if (k < 288) v = p.in[pb + 9][(size_t)(k - 128) * C + col];
        else if (l) v = p.in[34][(size_t)(k - 288) * C + col];
        ((bf16*)(ws + WS_LW))[((size_t)l * C + col) * 320 + k] = (bf16)(pk_bf16(v, 0.f) & 0xffffu);
    }
}

template <bool FROM_PARTIALS, bool ROUTE>
__device__ __forceinline__ void norm_mod_phase(const Params& p, const Ctx& c_, const float* x, const float* gain, int l, int shift_off, bf16* hout, const float* router) {
    const Ctx c = fresh_ctx(c_);
    LAS float* sh = (LAS float*)c.lds; LAS float* sc = sh + D;
    const int b = c.wg / 64;
    unsigned char* ws = fresh_ws(p);
    if (FROM_PARTIALS) {
        const float* mp = (const float*)(ws + WS_MODP); const float* mb = p.in[l ? 24 : 3];
        for (int i = c.tid; i < 2 * D; i += 512) { const int j = shift_off + i;
            float s = mb[j];
#pragma unroll
            for (int ks = 0; ks < KSPLIT; ++ks) s += mp[((size_t)(ks * 2 + l) * NB + b) * (6 * D) + j];
            sh[i] = s; }
        if (c.tid < 384) { const int idx = c.wg * 384 + c.tid; const int ll = idx / (NB * 6 * D), rem = idx % (NB * 6 * D), bb = rem / (6 * D), j = rem % (6 * D);
            float s = p.in[ll ? 24 : 3][j];
#pragma unroll
            for (int ks = 0; ks < KSPLIT; ++ks) s += mp[((size_t)(ks * 2 + ll) * NB + bb) * (6 * D) + j];
            ((float*)(ws + WS_MOD))[idx] = s; }
    } else {
        const float* md = (const float*)(ws + WS_MOD) + ((size_t)l * NB + b) * (6 * D) + shift_off;
        for (int i = c.tid; i < 2 * D; i += 512) sh[i] = md[i];
    }
    __syncthreads();
    for (int i = 0; i < 4; ++i) {
        const int m = c.wg * 32 + c.wave + 8 * i;
        const f32x4* xr = (const f32x4*)(x + (size_t)m * D) + c.lane;
        float ss = 0.f;
#pragma unroll
        for (int j = 0; j < 8; ++j) { const f32x4 t = xr[64 * j]; ss += (t[0] * t[0] + t[1] * t[1]) + (t[2] * t[2] + t[3] * t[3]); }
        ss = wave_sum(ss, c.lane);
        const float rn = 1.0f / sqrtf(ss * (1.0f / D) + 1e-6f);
        float lg[NE];
        if (ROUTE) {
#pragma unroll
            for (int e = 0; e < NE; ++e) lg[e] = 0.f; }
        u32x2* ho = (u32x2*)(hout + (size_t)m * D) + c.lane;
#pragma unroll 2
        for (int j = 0; j < 8; ++j) {
            const int d = 4 * (c.lane + 64 * j);
            const f32x4 g = *(const f32x4*)(gain + d); const f32x4 s1 = *(const LAS f32x4*)(sh + d); const f32x4 s2 = *(const LAS f32x4*)(sc + d);
            const f32x4 xv = xr[64 * j];
            f32x4 hv;
#pragma unroll
            for (int q = 0; q < 4; ++q) hv[q] = xv[q] * rn * g[q] * (1.0f + s2[q]) + s1[q];
            u32x2 w; w.x = pk_bf16(hv[0], hv[1]); w.y = pk_bf16(hv[2], hv[3]); ho[64 * j] = w;
            if (ROUTE) {
#pragma unroll
                for (int q = 0; q < 4; ++q) { const f32x4 r0 = *(const f32x4*)(router + (size_t)(d + q) * NE), r1 = *(const f32x4*)(router + (size_t)(d + q) * NE + 4);
                    lg[0] += hv[q] * r0[0]; lg[1] += hv[q] * r0[1]; lg[2] += hv[q] * r0[2]; lg[3] += hv[q] * r0[3];
                    lg[4] += hv[q] * r1[0]; lg[5] += hv[q] * r1[1]; lg[6] += hv[q] * r1[2]; lg[7] += hv[q] * r1[3]; } }
        }
        if (ROUTE) {
#pragma unroll
            for (int e = 0; e < NE; ++e) lg[e] = wave_sum(lg[e], c.lane);
            if (c.lane == 0) {
                int e1 = 0; float v1 = lg[0];
#pragma unroll
                for (int e = 1; e < NE; ++e) if (lg[e] > v1) { v1 = lg[e]; e1 = e; }
                int e2 = -1; float v2 = 0.f;
#pragma unroll
                for (int e = 0; e < NE; ++e) if (e != e1 && (e2 < 0 || lg[e] > v2)) { v2 = lg[e]; e2 = e; }
                const float p2 = __expf(v2 - v1); const float w1 = 1.0f / (1.0f + p2), w2 = p2 / (1.0f + p2);
                unsigned* cnt = (unsigned*)(ws + WS_CTL) + CW_CNT;
                const int pos1 = (int)__hip_atomic_fetch_add(cnt + 64 * e1, 1u, __ATOMIC_RELAXED, __HIP_MEMORY_SCOPE_AGENT);
                const int pos2 = (int)__hip_atomic_fetch_add(cnt + 64 * e2, 1u, __ATOMIC_RELAXED, __HIP_MEMORY_SCOPE_AGENT);
                int* te = (int*)(ws + WS_TOKE); int* tp = (int*)(ws + WS_TOKP); float* tw = (float*)(ws + WS_TOKW);
                te[2 * m] = e1; te[2 * m + 1] = e2; tp[2 * m] = pos1; tp[2 * m + 1] = pos2; tw[2 * m] = w1; tw[2 * m + 1] = w2;
            }
        }
    }
    __syncthreads();
}
__device__ __forceinline__ void moe_gather_phase(const Params& p, const Ctx& c_) {
    const Ctx c = fresh_ctx(c_);
    unsigned char* ws = fresh_ws(p);
    LAS int* tb = (LAS int*)(c.lds + LDSCTL_OFF + 64);
    const unsigned* cnt = (const unsigned*)(ws + WS_CTL) + CW_CNT;
    if (c.tid == 0) { int o = 0; for (int e = 0; e < NE; ++e) { tb[e] = o; o += ((int)__hip_atomic_load(cnt + 64 * e, __ATOMIC_RELAXED, __HIP_MEMORY_SCOPE_AGENT) + 255) >> 8; } tb[NE] = o; }
    __syncthreads();
    const int* te = (const int*)(ws + WS_TOKE); const int* tp = (const int*)(ws + WS_TOKP); int* ts = (int*)(ws + WS_TOKS);
    const bf16* h = (const bf16*)(ws + WS_H); unsigned char* am = ws + WS_REG + FX_AMOE;
    for (int i = 0; i < 4; ++i) {
        const int m = c.wg * 32 + c.wave + 8 * i;
        const u32x4* src = (const u32x4*)(h + (size_t)m * D) + c.lane;
        u32x2 v[4];
#pragma unroll
        for (int j = 0; j < 4; ++j) { const u32x4 w = src[64 * j];
            v[j].x = pg8::pk4_fp8_sat(bflo(w.x) * A8_SCALE, bfhi(w.x) * A8_SCALE, bflo(w.y) * A8_SCALE, bfhi(w.y) * A8_SCALE);
            v[j].y = pg8::pk4_fp8_sat(bflo(w.z) * A8_SCALE, bfhi(w.z) * A8_SCALE, bflo(w.w) * A8_SCALE, bfhi(w.w) * A8_SCALE); }
#pragma unroll
        for (int q = 0; q < 2; ++q) {
            const int slot = tb[te[2 * m + q]] * 256 + tp[2 * m + q];
            u32x2* dst = (u32x2*)(am + (size_t)slot * D) + c.lane;
#pragma unroll
            for (int j = 0; j < 4; ++j) dst[64 * j] = v[j];
            if (c.lane == 0) ts[2 * m + q] = slot;
        }
    }
    if (c.wg < NE) {
        const int e = c.wg; const int r0 = tb[e] * 256 + (int)__hip_atomic_load(cnt + 64 * e, __ATOMIC_RELAXED, __HIP_MEMORY_SCOPE_AGENT), r1 = tb[e + 1] * 256;
        const u32x4 z = {0u, 0u, 0u, 0u};
        for (int r = r0 + c.wave; r < r1; r += NWAVE) { u32x4* dst = (u32x4*)(am + (size_t)r * D) + c.lane; dst[0] = z; dst[64] = z; }
    }
}

template <int L>
__device__ __forceinline__ void prep_phase(const Params& p, const Ctx& c_) {
    const Ctx c = fresh_ctx(c_);
    constexpr int PB = L ? 23 : 2, Q = PB + 10 + (L ? 2 : 0);
    unsigned char* ws = fresh_ws(p);
    const bf16* proj = (const bf16*)(ws + WS_REG + MX_PROJ);
    const float* mu = p.in[PB + 4]; const float* w0 = p.in[PB + 5]; const float* a0 = p.in[PB + 7];
    const float* v0 = L ? p.in[PB + 10] : nullptr;
    const float* k_k = p.in[Q + 0]; const float* k_a = p.in[Q + 1]; const float* r_k = p.in[Q + 2];
    const bf16* lw = (const bf16*)(ws + WS_LW) + (size_t)L * C * 320;
    unsigned char* sin_ = ws + WS_REG + MX_SIN; bf16* sV = (bf16*)(ws + WS_REG + MX_SV); bf16* sG = (bf16*)(ws + WS_REG + MX_SG);
    bf16* vf = (bf16*)(ws + WS_VF); float* rkb = (float*)(ws + WS_RKB);
    constexpr int LZB = 656;
    LAS unsigned char* lz = c.lds;
    const int m0 = c.wg * 32;
#pragma unroll 1
    for (int rep_ = 0; rep_ < (REP_PHASE == 33 ? 2 : 1); ++rep_)
    { const int tk = c.tid >> 4, sub = c.tid & 15, m = m0 + tk; const bool has_prev = (m % T) != 0;
      const bf16* cur = proj + (size_t)m * NPP + 3072; const bf16* prv = cur - NPP;
#pragma unroll
      for (int i = 0; i < 10; ++i) { const int ic = 2 * (sub + 16 * i);
          unsigned o = 0u;
          if (L == 1 || ic < 288) {
              const unsigned cw = *(const unsigned*)(cur + ic); const unsigned pw = has_prev ? *(const unsigned*)(prv + ic) : 0u; const f32x2 mm = *(const f32x2*)(mu + 3072 + ic);
              float z0 = bflo(cw) + (bflo(pw) - bflo(cw)) * mm[0], z1 = bfhi(cw) + (bfhi(pw) - bfhi(cw)) * mm[1];
              if (ic < 64) { z0 = 1.0f - 2.0f / (1.0f + __expf(2.0f * z0)); z1 = 1.0f - 2.0f / (1.0f + __expf(2.0f * z1)); }
              else if (ic >= 128 && ic < 288) { z0 = sigmoid_f(z0); z1 = sigmoid_f(z1); }
              o = pk_bf16(z0, z1); }
          *(LAS unsigned*)(lz + tk * LZB + ic * 2) = o; } }
    __syncthreads();
    const int lane = c.lane, ti = lane & 15, g = lane >> 4;
    f32x4 acc[4];
#define LORA_MMA(KOFF, KSTEPS) do { bf16x8 wf_[KSTEPS][4]; \
        _Pragma("unroll") for (int ks = 0; ks < (KSTEPS); ++ks) _Pragma("unroll") for (int ct = 0; ct < 4; ++ct) wf_[ks][ct] = *(const bf16x8*)(lw + (size_t)(cbase + 16 * ct + ti) * 320 + (KOFF) + 32 * ks + 8 * g); \
        __builtin_amdgcn_sched_barrier(0);     \
        _Pragma("unroll") for (int ct = 0; ct < 4; ++ct) acc[ct] = (f32x4){0.f, 0.f, 0.f, 0.f}; \
        _Pragma("unroll") for (int ks = 0; ks < (KSTEPS); ++ks) { \
            const bf16x8 af = *(const LAS bf16x8*)(lz + (16 * tt + ti) * LZB + ((KOFF) + 32 * ks + 8 * g) * 2); \
            _Pragma("unroll") for (int ct = 0; ct < 4; ++ct) acc[ct] = __builtin_amdgcn_mfma_f32_16x16x32_bf16(wf_[ks][ct], af, acc[ct], 0, 0, 0); } } while (0)
#define SHIFT4(seg, cl, out) do { const u32x2 cw_ = *(const LAS u32x2*)(stg + (ti + 1) * 400 + (seg) * 128 + (cl) * 2), pw_ = *(const LAS u32x2*)(stg + ti * 400 + (seg) * 128 + (cl) * 2); \
        const f32x4 mu_ = *(const LAS f32x4*)(prm + (seg) * 64 + (cl)); \
        out[0] = bflo(cw_.x) + (bflo(pw_.x) - bflo(cw_.x)) * mu_[0]; out[1] = bfhi(cw_.x) + (bfhi(pw_.x) - bfhi(cw_.x)) * mu_[1]; \
        out[2] = bflo(cw_.y) + (bflo(pw_.y) - bflo(cw_.y)) * mu_[2]; out[3] = bfhi(cw_.y) + (bfhi(pw_.y) - bfhi(cw_.y)) * mu_[3]; } while (0)
    LAS unsigned char* stg = c.lds + 24576 + c.wave * 9216;
    LAS float* prm = (LAS float*)(stg + 6912);
#pragma unroll 1
    for (int it_ = 0; it_ < (REP_PHASE == 31 ? 8 : 4); ++it_) {
        const int it = it_ & 3, tt = c.wave & 1;
        const int head = 4 * (c.wave >> 1) + it, cbase = 64 * head;
        const int m = m0 + 16 * tt + ti;
#pragma unroll 1
        for (int rep0_ = 0; rep0_ < (REP_PHASE == 38 ? 3 : 1); ++rep0_)
        { const int mr0 = m0 + 16 * tt - 1; const bool first_zero = ((m0 + 16 * tt) % T) == 0;
          u32x4 sv_[7]; f32x4 pv_[3];
#pragma unroll
          for (int i = 0; i < 7; ++i) { int id = lane + 64 * i; id = id < 17 * 24 ? id : 17 * 24 - 1; const int row = id / 24, ch = id % 24, seg = ch >> 3, part = ch & 7;
              const int rr_ = (first_zero && row == 0) ? 1 : row;
              sv_[i] = *(const u32x4*)(proj + (size_t)(mr0 + rr_) * NPP + seg * 1024 + cbase + part * 8); }
#pragma unroll
          for (int i = 0; i < 3; ++i) { int id = lane + 64 * i; id = id < (L ? 144 : 128) ? id : 0; const int pi = id >> 4, part = id & 15;
              const float* src = pi < 3 ? mu + pi * 1024 : pi == 3 ? w0 : pi == 4 ? a0 : pi == 5 ? k_k : pi == 6 ? k_a : pi == 7 ? r_k : v0;
              pv_[i] = *(const f32x4*)(src + cbase + part * 4); }
          __builtin_amdgcn_sched_barrier(0);
#pragma unroll
          for (int i = 0; i < 7; ++i) { const int id = lane + 64 * i; if (id < 17 * 24) { const int row = id / 24, ch = id % 24, seg = ch >> 3, part = ch & 7;
              u32x4 v = sv_[i]; if (first_zero && row == 0) v = (u32x4){0u, 0u, 0u, 0u};
              *(LAS u32x4*)(stg + row * 400 + seg * 128 + part * 16) = v; } }
#pragma unroll
          for (int i = 0; i < 3; ++i) { const int id = lane + 64 * i; if (id < (L ? 144 : 128)) *(LAS f32x4*)(prm + (id >> 4) * 64 + (id & 15) * 4) = pv_[i]; }
          LDS_WAIT(); asm volatile("" ::: "memory"); }
        unsigned char* srec = sin_ + ((size_t)((m / T) * H + head) * T + (m % T)) * 768;
#pragma unroll 1
        for (int rep1_ = 0; rep1_ < (REP_PHASE == 36 ? 3 : 1); ++rep1_) {
        LORA_MMA(0, 2);
#pragma unroll
        for (int ct = 0; ct < 4; ++ct) { const f32x4 b4 = *(const LAS f32x4*)(prm + 3 * 64 + 16 * ct + 4 * g); f32x4 o;
#pragma unroll
            for (int r = 0; r < 4; ++r) { const float nsw = -(acc[ct][r] + b4[r]); const float sp = nsw > 20.f ? nsw : __logf(1.0f + __expf(nsw)); o[r] = __expf(-__expf(-sp - 0.5f)); }
            *(f32x4*)(srec + (16 * ct + 4 * g) * 4) = o; }
        }
#pragma unroll 1
        for (int rep2_ = 0; rep2_ < (REP_PHASE == 35 ? 3 : 1); ++rep2_) {
        LORA_MMA(64, 2);
        { f32x4 kkv[4], av[4]; float ss = 0.f, bs = 0.f;
#pragma unroll
          for (int ct = 0; ct < 4; ++ct) { const int cl = 16 * ct + 4 * g;
              const f32x4 ab = *(const LAS f32x4*)(prm + 4 * 64 + cl), kk4 = *(const LAS f32x4*)(prm + 5 * 64 + cl), ka4 = *(const LAS f32x4*)(prm + 6 * 64 + cl), rk4 = *(const LAS f32x4*)(prm + 7 * 64 + cl);
              float rr[4], kv[4]; SHIFT4(0, cl, rr); SHIFT4(1, cl, kv);
              f32x4 km, r4;
#pragma unroll
              for (int r = 0; r < 4; ++r) { const float a_ = sigmoid_f(acc[ct][r] + ab[r]); av[ct][r] = a_; const float n_ = kv[r] * kk4[r]; kkv[ct][r] = n_; ss += n_ * n_;
                  km[r] = kv[r] * (1.0f + (a_ - 1.0f) * ka4[r]); r4[r] = rr[r]; bs += rr[r] * km[r] * rk4[r]; }
              *(u32x2*)(srec + 512 + (16 * ct + 4 * g) * 2) = (u32x2){pk_bf16(km[0], km[1]), pk_bf16(km[2], km[3])}; *(u32x2*)(srec + 640 + (16 * ct + 4 * g) * 2) = (u32x2){pk_bf16(r4[0], r4[1]), pk_bf16(r4[2], r4[3])}; }
          ss += xor_lane(ss, lane, 16); ss += xor_lane(ss, lane, 32); bs += xor_lane(bs, lane, 16); bs += xor_lane(bs, lane, 32);
          const float inv = 1.0f / sqrtf(fmaxf(ss, 1e-24f));
#pragma unroll
          for (int ct = 0; ct < 4; ++ct) { const f32x4 n4 = kkv[ct] * inv, nb = n4 * av[ct]; *(u32x2*)(srec + 256 + (16 * ct + 4 * g) * 2) = (u32x2){pk_bf16(-n4[0], -n4[1]), pk_bf16(-n4[2], -n4[3])};
              *(u32x2*)(srec + 384 + (16 * ct + 4 * g) * 2) = (u32x2){pk_bf16(nb[0], nb[1]), pk_bf16(nb[2], nb[3])}; }
          if (g == 0) rkb[(size_t)m * H + head] = bs; }
        }
#pragma unroll 1
        for (int rep_ = 0; rep_ < (REP_PHASE == 34 ? 3 : 1); ++rep_) {
        LORA_MMA(128, 5);
#pragma unroll
        for (int ct = 0; ct < 4; ++ct) *(u32x2*)(sG + (size_t)m * C + cbase + 16 * ct + 4 * g) = (u32x2){pk_bf16(acc[ct][0], acc[ct][1]), pk_bf16(acc[ct][2], acc[ct][3])};
        }
#pragma unroll 1
        for (int rep4_ = 0; rep4_ < (REP_PHASE == 37 ? 3 : 1); ++rep4_) {
        if (L == 1) LORA_MMA(288, 1);
#pragma unroll
        for (int ct = 0; ct < 4; ++ct) { const int cl = 16 * ct + 4 * g, c4 = cbase + cl; float vv[4]; SHIFT4(2, cl, vv); f32x4 o = {vv[0], vv[1], vv[2], vv[3]};
            const size_t off = (size_t)m * C + c4;
            if (L == 0) *(u32x2*)(vf + off) = (u32x2){pk_bf16(o[0], o[1]), pk_bf16(o[2], o[3])};
            else { const u32x2 fw = *(const u32x2*)(vf + off); const f32x4 f = {bflo(fw.x), bfhi(fw.x), bflo(fw.y), bfhi(fw.y)}, vb = *(const LAS f32x4*)(prm + 8 * 64 + cl);
#pragma unroll
                for (int r = 0; r < 4; ++r) o[r] = o[r] + (f[r] - o[r]) * sigmoid_f(acc[ct][r] + vb[r]); }
            *(u32x2*)(sV + off) = (u32x2){pk_bf16(o[0], o[1]), pk_bf16(o[2], o[3])}; }
        }
    }
#undef LORA_MMA
#undef SHIFT4
    __syncthreads();
#pragma unroll 1
    for (int rep_ = 0; rep_ < (REP_PHASE == 32 ? 2 : 1); ++rep_)
    { constexpr int NR = L ? NR1 : NR0;
      const int n = c.wg % NBLK, hh = (c.wg / NBLK) % MH, b = c.wg / (NBLK * MH);
      LAS float* red = (LAS float*)c.lds;
      const int d4 = c.tid & 31, rg = c.tid >> 5;
      float s0 = 0.f, s1 = 0.f, s2 = 0.f, s3 = 0.f;
      for (int i = 0; i < 16; ++i) { const u32x2 w = *(const u32x2*)(proj + (size_t)(b * T + n * MBS + rg * 16 + i) * NPP + NR + 1024 + hh * MD + 4 * d4);
          s0 += bflo(w.x); s1 += bfhi(w.x); s2 += bflo(w.y); s3 += bfhi(w.y); }
      *(LAS f32x4*)(red + rg * 128 + 4 * d4) = (f32x4){s0, s1, s2, s3};
      __syncthreads();
      if (c.tid < 128) { float s = 0.f;
#pragma unroll
          for (int i = 0; i < 16; ++i) s += red[i * 128 + c.tid];
          ((float*)(ws + WS_KMEAN))[(size_t)c.wg * MD + c.tid] = s * (1.0f / MBS); }
      __syncthreads();
      bf16* vt = (bf16*)(ws + WS_REG + MX_VT);
#pragma unroll
      for (int i = 0; i < 8; ++i) { const int id = c.tid + 512 * i, key = id >> 4, part = id & 15;
          const u32x4 v = *(const u32x4*)(proj + (size_t)(b * T + n * MBS + key) * NPP + NR + 2048 + hh * MD + part * 8);
          *(LAS u32x4*)(c.lds + key * 256 + part * 16) = v; }
      __syncthreads();
#pragma unroll
      for (int i = 0; i < 8; ++i) { const int d = c.lane + 64 * (i & 1), kc = c.wave + 8 * (i >> 1);
          const LAS unsigned short* q = (const LAS unsigned short*)(c.lds + (8 * kc) * 256 + 2 * d);
          u32x4 o; o.x = q[0] | ((unsigned)q[128] << 16); o.y = q[256] | ((unsigned)q[384] << 16); o.z = q[512] | ((unsigned)q[640] << 16); o.w = q[768] | ((unsigned)q[896] << 16);
          *(u32x4*)(vt + ((size_t)(b * MH + hh) * MD + d) * T + n * MBS + 8 * kc) = o; }
      __syncthreads(); }
}

template <int SCAN_ID>
__device__ __forceinline__ void scan_phase(const Params& p, const Ctx& c_) {
    const Ctx c = fresh_ctx(c_);
    unsigned char* ws = fresh_ws(p);
    const unsigned char* sin_ = ws + WS_REG + MX_SIN;
    const bf16* sV = (const bf16*)(ws + WS_REG + MX_SV); float* sY = (float*)(ws + WS_REG + MX_SY);
    const int xcd = c.wg & 7, j = c.wg >> 3, bh = xcd * 8 + (j >> 2), rq = j & 3, b = bh / H, h = bh % H;
    constexpr int TC = 32, NCH = T / TC, BUF = TC * 320;
    LAS float* inb = (LAS float*)c.lds;
    LAS float* vb = inb + 2 * BUF;
    LAS float* yb = vb + 2 * TC * 16;
    const unsigned char* src = sin_ + (size_t)bh * T * 768;
    constexpr int CHB = TC * 768;
#define SCAN_PARK(bufbase) do { _Pragma("unroll") for (int i = 0; i < 6; ++i) { const int pid = tl + 256 * i, t_ = pid / 48, pp = pid % 48; LAS float* d_ = (bufbase) + t_ * 320; \
        if (pp < 16) *(LAS f32x4*)(d_ + 64 + 4 * pp) = __builtin_bit_cast(f32x4, pre[i]); \
        else { const int qq = (pp - 16) >> 3, col = 8 * ((pp - 16) & 7), qd = qq == 0 ? 0 : qq + 1; const u32x4 w_ = pre[i]; \
            *(LAS f32x4*)(d_ + qd * 64 + col) = (f32x4){bflo(w_.x), bfhi(w_.x), bflo(w_.y), bfhi(w_.y)}; *(LAS f32x4*)(d_ + qd * 64 + col + 4) = (f32x4){bflo(w_.z), bfhi(w_.z), bflo(w_.w), bfhi(w_.w)}; } } } while (0)
    const size_t gv = (size_t)b * T * C + h * HN + 16 * rq;
    const bool loader = c.wave >= 4;
    const int tl = c.tid - 256;
    u32x4 pre[6]; float pv0 = 0.f, pv1 = 0.f;
    LAS unsigned* bscr = (LAS unsigned*)(c.lds + 90112 + (c.wave & 3) * 8448);
    const int lwid = c.wg * 4 + (c.wave & 3);
    if (loader) {
#pragma unroll
        for (int i = 0; i < 6; ++i) pre[i] = *(const u32x4*)(src + 16 * (tl + 256 * i));
        pv0 = bf2f(sV[gv + (size_t)(tl >> 4) * C + (tl & 15)]); pv1 = bf2f(sV[gv + (size_t)(16 + (tl >> 4)) * C + (tl & 15)]);
        SCAN_PARK(inb);
        vb[tl] = pv0; vb[256 + tl] = pv1;
#pragma unroll
        for (int i = 0; i < 6; ++i) pre[i] = *(const u32x4*)(src + (size_t)CHB + 16 * (tl + 256 * i));
        pv0 = bf2f(sV[gv + (size_t)(TC + (tl >> 4)) * C + (tl & 15)]); pv1 = bf2f(sV[gv + (size_t)(TC + 16 + (tl >> 4)) * C + (tl & 15)]);
    }
    const int rs = c.lane >> 4, cg = c.lane & 15;
    __syncthreads();
    if (!loader) {
        f32x4 S = {0.f, 0.f, 0.f, 0.f};
        __builtin_amdgcn_s_setprio(3);
        for (int ch = 0; ch < NCH; ++ch) {
            const int cur = ch & 1;
            const LAS float* ib = inb + cur * BUF + 4 * cg; const LAS float* vv = vb + cur * TC * 16 + 4 * c.wave + rs;
            LAS float* yo = yb + cur * TC * 16 + 4 * c.wave + rs;
            f32x4 a4 = *(const LAS f32x4*)(ib), w4 = *(const LAS f32x4*)(ib + 64), b4 = *(const LAS f32x4*)(ib + 128), k4 = *(const LAS f32x4*)(ib + 192), r4 = *(const LAS f32x4*)(ib + 256);
            float vi = vv[0];
            float yacc = 0.f;
#pragma unroll
            for (int t = 0; t < TC; ++t) {
                f32x4 a4n = a4, w4n = w4, b4n = b4, k4n = k4, r4n = r4; float vin = vi;
                if (t + 1 < TC) { const LAS float* nb = ib + (t + 1) * 320;
                    a4n = *(const LAS f32x4*)(nb); w4n = *(const LAS f32x4*)(nb + 64); b4n = *(const LAS f32x4*)(nb + 128); k4n = *(const LAS f32x4*)(nb + 192); r4n = *(const LAS f32x4*)(nb + 256); vin = vv[(t + 1) * 16]; }
                float sa = (S[0] * a4[0] + S[1] * a4[1]) + (S[2] * a4[2] + S[3] * a4[3]);
                sa = row16_sum(sa);
                S = S * w4 + sa * b4 + vi * k4;
                float y = (S[0] * r4[0] + S[1] * r4[1]) + (S[2] * r4[2] + S[3] * r4[3]);
                y = row16_sum(y);
                yacc = (cg == (t & 15)) ? y : yacc;
                if ((t & 15) == 15) yo[((t & 16) + cg) * 16] = yacc;
                a4 = a4n; w4 = w4n; b4 = b4n; k4 = k4n; r4 = r4n; vi = vin;
            }
            __syncthreads();
        }
        __builtin_amdgcn_s_setprio(0);
    } else {
        f32x2 cvA[32], cvB[32]; ConvJob bjA, bjB; bool pendA = false, pendB = false;
        constexpr int BG_HALF = (BG_TOTAL + 1) / 2;
#define SCAN_LOADER_ITER(ch_, cvX, bjX, pendX) do { const int cur = (ch_) & 1; \
            if ((ch_) + 1 < NCH) { SCAN_PARK(inb + (cur ^ 1) * BUF); vb[(cur ^ 1) * TC * 16 + tl] = pv0; vb[(cur ^ 1) * TC * 16 + 256 + tl] = pv1; } \
            if ((ch_) + 2 < NCH) { const unsigned char* s2 = src + (size_t)((ch_) + 2) * CHB; \
                _Pragma("unroll") for (int i = 0; i < 6; ++i) pre[i] = *(const u32x4*)(s2 + 16 * (tl + 256 * i)); \
                const size_t o = gv + (size_t)(((ch_) + 2) * TC) * C; \
                pv0 = bf2f(sV[o + (size_t)(tl >> 4) * C + (tl & 15)]); pv1 = bf2f(sV[o + (size_t)(16 + (tl >> 4)) * C + (tl & 15)]); } \
            if ((ch_) > 0) { const size_t o = gv + (size_t)(((ch_) - 1) * TC) * C; const LAS float* ys = yb + (cur ^ 1) * TC * 16; \
                sY[o + (size_t)(tl >> 4) * C + (tl & 15)] = ys[tl]; sY[o + (size_t)(16 + (tl >> 4)) * C + (tl & 15)] = ys[256 + tl]; } \
            if (pendX) { conv_finish(bjX, cvX, bscr, c.lane); pendX = false; } \
            if (((ch_) & 7) < 5) { const int bi = SCAN_ID * BG_HALF + (((ch_) >> 3) * 5 + ((ch_) & 7)) * (NWG * 4) + lwid; \
                if (bi < (SCAN_ID ? BG_TOTAL : BG_HALF)) { bjX = bg_job(p, ws, bi); conv_issue(bjX, cvX, c.lane); pendX = true; } } \
            __syncthreads(); } while (0)
        for (int ch = 0; ch < NCH; ch += 2) { SCAN_LOADER_ITER(ch, cvA, bjA, pendA); SCAN_LOADER_ITER(ch + 1, cvB, bjB, pendB); }
#undef SCAN_LOADER_ITER
        { const size_t o = gv + (size_t)((NCH - 1) * TC) * C; const LAS float* ys = yb + ((NCH - 1) & 1) * TC * 16;
          sY[o + (size_t)(tl >> 4) * C + (tl & 15)] = ys[tl]; sY[o + (size_t)(16 + (tl >> 4)) * C + (tl & 15)] = ys[256 + tl];
          if (pendA) conv_finish(bjA, cvA, bscr, c.lane); if (pendB) conv_finish(bjB, cvB, bscr, c.lane); }
    }
    __syncthreads();
#undef SCAN_PARK
}


template <int L>
__device__ __forceinline__ void mix_post_phase(const Params& p, const Ctx& c_) {
    const Ctx c = fresh_ctx(c_);
    constexpr int PB = L ? 23 : 2, Q = PB + 10 + (L ? 2 : 0);
    unsigned char* ws = fresh_ws(p);
    const float* ln_w = p.in[Q + 3]; const float* ln_b = p.in[Q + 4];
    const float* sY = (const float*)(ws + WS_REG + MX_SY); const bf16* sV = (const bf16*)(ws + WS_REG + MX_SV); const bf16* sG = (const bf16*)(ws + WS_REG + MX_SG);
    const float* rkb = (const float*)(ws + WS_RKB); bf16* cat = (bf16*)(ws + WS_CAT);
    const int gw = c.wg * NWAVE + c.wave, hl = c.lane >> 4;
    for (int it = gw; it < 4 * M; it += NGW) {
        const int m = it >> 2, ch = (it & 3) * 256 + 4 * c.lane, h = ch >> 6;
        const size_t o = (size_t)m * C + ch;
        const f32x4 y = *(const f32x4*)(sY + o);
        const u32x2 vw = *(const u32x2*)(sV + o), gw_ = *(const u32x2*)(sG + o);
        const f32x4 lw4 = *(const f32x4*)(ln_w + ch), lb4 = *(const f32x4*)(ln_b + ch);
        const float bon = rkb[(size_t)m * H + h];
        const float mean = row16_sum((y[0] + y[1]) + (y[2] + y[3])) * (1.0f / 64.0f);
        const f32x4 dy = y - mean;
        const float var = row16_sum((dy[0] * dy[0] + dy[1] * dy[1]) + (dy[2] * dy[2] + dy[3] * dy[3])) * (1.0f / 64.0f);
        const float rs = 1.0f / sqrtf(var + 64e-5f);
        const f32x4 v4 = {bflo(vw.x), bfhi(vw.x), bflo(vw.y), bfhi(vw.y)}, g4 = {bflo(gw_.x), bfhi(gw_.x), bflo(gw_.y), bfhi(gw_.y)};
        const f32x4 ov = (dy * rs * lw4 + lb4 + bon * v4) * g4;
        *(u32x2*)(cat + (size_t)m * D + ch) = (u32x2){pk_bf16(ov[0], ov[1]), pk_bf16(ov[2], ov[3])};
    }
    (void)hl;
    __syncthreads();
}

template <int L>
__device__ __forceinline__ void moba_phase(const Params& p, const Ctx& c_) {
    const Ctx c = fresh_ctx(c_);
    constexpr int PB = L ? 23 : 2, Q = PB + 10 + (L ? 2 : 0), NR = L ? NR1 : NR0;
    unsigned char* ws = fresh_ws(p);
    const bf16* proj = (const bf16*)(ws + WS_REG + MX_PROJ); const bf16* vt = (const bf16*)(ws + WS_REG + MX_VT);
    const float* kmean = (const float*)(ws + WS_KMEAN); const float* gain = p.in[Q + 5]; bf16* cat = (bf16*)(ws + WS_CAT);
    const int hf0 = c.wg & 1, pr = (c.wg >> 1) & 3, h = (c.wg >> 3) & 7, b = c.wg >> 6;
    const int lane = c.lane, qi = lane & 15, g = lane >> 4;
    const float slope = exp2f(-(float)(h + 1)), scale = 0.08838834764831845f;
    constexpr int KROW = 272, VROW = 272, KBUF = 64 * KROW, VBUF = 128 * VROW;
    LAS unsigned char* KB = c.lds; LAS unsigned char* VB = c.lds + 2 * KBUF;
    const bf16* kbase = proj + (size_t)(b * T) * NPP + NR + 1024 + h * MD;
    const bf16* vbase = vt + (size_t)(b * MH + h) * MD * T;
    u32x4 stg[4];
#define MOBA_LOAD(key0) do { _Pragma("unroll") for (int i_ = 0; i_ < 2; ++i_) { const int id_ = c.tid + 512 * i_; \
        stg[i_] = *(const u32x4*)(kbase + (size_t)((key0) + (id_ >> 4)) * NPP + (id_ & 15) * 8); \
        stg[2 + i_] = *(const u32x4*)(vbase + (size_t)(id_ >> 3) * T + (key0) + (id_ & 7) * 8); } } while (0)
#define MOBA_STORE(buf) do { _Pragma("unroll") for (int i_ = 0; i_ < 2; ++i_) { const int id_ = c.tid + 512 * i_; \
        *(LAS u32x4*)(KB + (buf) * KBUF + (id_ >> 4) * KROW + (id_ & 15) * 16) = stg[i_]; \
        *(LAS u32x4*)(VB + (buf) * VBUF + (id_ >> 3) * VROW + (id_ & 7) * 16) = stg[2 + i_]; } } while (0)
    constexpr float LOG2E = 1.4426950408889634f;
    const float slope2 = slope * LOG2E, qscale = scale * LOG2E;
    for (int uu = 0; uu < 2; ++uu) {
        const int own = uu ? 7 - pr : pr, hf = uu ? 1 - hf0 : hf0;
        const int tq = own * MBS + hf * 128 + 16 * c.wave + qi;
        const int tq_lo = own * MBS + hf * 128 + 16 * c.wave;
        const size_t mrow = (size_t)(b * T + tq);
        bf16x8 qf[4];
#pragma unroll
        for (int ds = 0; ds < 4; ++ds) { const u32x4 qw = *(const u32x4*)(proj + mrow * NPP + NR + h * MD + 32 * ds + 8 * g);
            u32x4 o; o.x = pk_bf16(bflo(qw.x) * qscale, bfhi(qw.x) * qscale); o.y = pk_bf16(bflo(qw.y) * qscale, bfhi(qw.y) * qscale);
            o.z = pk_bf16(bflo(qw.z) * qscale, bfhi(qw.z) * qscale); o.w = pk_bf16(bflo(qw.w) * qscale, bfhi(qw.w) * qscale); qf[ds] = __builtin_bit_cast(bf16x8, o); }
        unsigned selmask = 0u;
        {
            float gt[8];
#pragma unroll
            for (int n = 0; n < 8; ++n) {
                float s = 0.f;
                if (n < own) {
                    const float* km = kmean + ((size_t)(b * MH + h) * NBLK + n) * MD + 8 * g;
#pragma unroll
                    for (int ds = 0; ds < 4; ++ds) { const f32x4 k0 = *(const f32x4*)(km + 32 * ds), k1 = *(const f32x4*)(km + 32 * ds + 4);
                        const u32x4 qw = __builtin_bit_cast(u32x4, qf[ds]);
                        s += bflo(qw.x) * k0[0] + bfhi(qw.x) * k0[1] + bflo(qw.y) * k0[2] + bfhi(qw.y) * k0[3] + bflo(qw.z) * k1[0] + bfhi(qw.z) * k1[1] + bflo(qw.w) * k1[2] + bfhi(qw.w) * k1[3]; }
                    s += xor_lane(s, lane, 16); s += xor_lane(s, lane, 32);
                }
                gt[n] = s;
            }
            const int nsel = own < 3 ? own : 3;
#pragma unroll
            for (int s = 0; s < 3; ++s) if (s < nsel) {
                int best = -1; float bv = 0.f;
#pragma unroll
                for (int n = 0; n < 8; ++n) { const bool cand = (n < own) && !((selmask >> n) & 1u); if (cand && (best < 0 || gt[n] > bv)) { best = n; bv = gt[n]; } }
                selmask |= 1u << best;
            }
        }
        const int nsteps = own * 4 + (hf ? 4 : 2);
        float m_run = -1e30f, l_run = 0.f;
        f32x4 acc[8];
#pragma unroll
        for (int dt = 0; dt < 8; ++dt) acc[dt] = (f32x4){0.f, 0.f, 0.f, 0.f};
#define MOBA_LDSBAR() do { asm volatile("s_waitcnt lgkmcnt(0)" ::: "memory"); __builtin_amdgcn_s_barrier(); asm volatile("" ::: "memory"); } while (0)
#define MOBA_LOADR(dst, key0) do { _Pragma("unroll") for (int i_ = 0; i_ < 2; ++i_) { const int id_ = c.tid + 512 * i_; \
        dst[i_] = *(const u32x4*)(kbase + (size_t)((key0) + (id_ >> 4)) * NPP + (id_ & 15) * 8); \
        dst[2 + i_] = *(const u32x4*)(vbase + (size_t)(id_ >> 3) * T + (key0) + (id_ & 7) * 8); } } while (0)
#define MOBA_STORER(src, buf) do { _Pragma("unroll") for (int i_ = 0; i_ < 2; ++i_) { const int id_ = c.tid + 512 * i_; \
        *(LAS u32x4*)(KB + (buf) * KBUF + (id_ >> 4) * KROW + (id_ & 15) * 16) = src[i_]; \
          \
        { const int part_ = id_ & 7, grp_ = part_ >> 2, q_ = part_ & 3, t_ = q_ >> 1, g0_ = 2 * (q_ & 1); LAS unsigned char* vd_ = VB + (buf) * VBUF + (id_ >> 3) * VROW + grp_ * 64 + t_ * 8; \
          *(LAS u32x2*)(vd_ + g0_ * 16) = (u32x2){src[2 + i_].x, src[2 + i_].y}; *(LAS u32x2*)(vd_ + (g0_ + 1) * 16) = (u32x2){src[2 + i_].z, src[2 + i_].w}; } } } while (0)
#define MOBA_STEP(step_, buf_) do { const int step = (step_), buf = (buf_); const int kb = step >> 2, key0 = step * 64; (void)buf; \
            const bool mine = (kb == own) || ((selmask >> kb) & 1u); \
            if (__any(mine)) { \
                const LAS unsigned char* kt_ = KB + buf * KBUF + qi * KROW + 16 * g; \
                f32x4 st[4]; \
_Pragma("unroll") \
                for (int kt = 0; kt < 4; ++kt) { st[kt] = (f32x4){0.f, 0.f, 0.f, 0.f}; \
_Pragma("unroll") \
                    for (int ds = 0; ds < 4; ++ds) { const bf16x8 kf = *(const LAS bf16x8*)(kt_ + kt * 16 * KROW + ds * 64); st[kt] = __builtin_amdgcn_mfma_f32_16x16x32_bf16(kf, qf[ds], st[kt], 0, 0, 0); } } \
                const float base = slope2 * (float)(key0 + 4 * g - tq); \
                float mx = -1e30f; \
                if (kb == own && key0 + 63 > tq_lo) {                                \
_Pragma("unroll") \
                    for (int kt = 0; kt < 4; ++kt) \
_Pragma("unroll") \
                        for (int r = 0; r < 4; ++r) { const int kp = key0 + 16 * kt + 4 * g + r; \
                            const float sv = st[kt][r] + (base + slope2 * (float)(16 * kt + r)); \
                            st[kt][r] = (kp <= tq) ? sv : -1e30f; mx = fmaxf(mx, st[kt][r]); } \
                } else {                                                              \
_Pragma("unroll") \
                    for (int kt = 0; kt < 4; ++kt) \
_Pragma("unroll") \
                        for (int r = 0; r < 4; ++r) { st[kt][r] += base + slope2 * (float)(16 * kt + r); mx = fmaxf(mx, st[kt][r]); } \
                } \
                mx = mine ? mx : -1e30f;                                              \
                mx = fmaxf(mx, xor_lane(mx, lane, 16)); mx = fmaxf(mx, xor_lane(mx, lane, 32)); \
                const float m_new = fmaxf(m_run, mx); \
                const float alpha = __builtin_amdgcn_exp2f(m_run - m_new); \
                m_run = m_new; \
                const float m_eff = mine ? m_new : 1e30f; \
                float ps = 0.f; \
_Pragma("unroll") \
                for (int kt = 0; kt < 4; ++kt) \
_Pragma("unroll") \
                    for (int r = 0; r < 4; ++r) { const float pv = __builtin_amdgcn_exp2f(st[kt][r] - m_eff); st[kt][r] = pv; ps += pv; } \
                l_run = l_run * alpha + ps; \
_Pragma("unroll") \
                for (int dt = 0; dt < 8; ++dt) acc[dt] = acc[dt] * alpha; \
                const LAS unsigned char* vt_ = VB + buf * VBUF + qi * VROW + 16 * g; \
_Pragma("unroll") \
                for (int kk = 0; kk < 2; ++kk) { \
                    u32x4 pw; pw.x = pk_bf16(st[2 * kk][0], st[2 * kk][1]); pw.y = pk_bf16(st[2 * kk][2], st[2 * kk][3]); pw.z = pk_bf16(st[2 * kk + 1][0], st[2 * kk + 1][1]); pw.w = pk_bf16(st[2 * kk + 1][2], st[2 * kk + 1][3]); \
                    const bf16x8 pf = __builtin_bit_cast(bf16x8, pw); \
_Pragma("unroll") \
                    for (int dt = 0; dt < 8; ++dt) { const bf16x8 vw = *(const LAS bf16x8*)(vt_ + dt * 16 * VROW + kk * 64); \
                        acc[dt] = __builtin_amdgcn_mfma_f32_16x16x32_bf16(vw, pf, acc[dt], 0, 0, 0); } \
                } \
            } \
            } while (0)
        u32x4 sa_[4], sb_[4];
        __syncthreads();
        MOBA_LOADR(sa_, 0); MOBA_STORER(sa_, 0);
        MOBA_LOADR(sb_, 64);
        if (nsteps > 2) MOBA_LOADR(sa_, 128);
        MOBA_LDSBAR();
        for (int st2 = 0; st2 < nsteps; st2 += 2) {
            MOBA_STEP(st2, 0);
            MOBA_STORER(sb_, 1);
            if (st2 + 3 < nsteps) MOBA_LOADR(sb_, (st2 + 3) * 64);
            MOBA_LDSBAR();
            MOBA_STEP(st2 + 1, 1);
            if (st2 + 2 < nsteps) MOBA_STORER(sa_, 0);
            if (st2 + 4 < nsteps) MOBA_LOADR(sa_, (st2 + 4) * 64);
            MOBA_LDSBAR();
        }
#undef MOBA_STEP
#undef MOBA_LOADR
#undef MOBA_STORER
#undef MOBA_LDSBAR
        l_run += xor_lane(l_run, lane, 16); l_run += xor_lane(l_run, lane, 32);
        const float inv = 1.0f / l_run;
        float ss = 0.f;
#pragma unroll
        for (int dt = 0; dt < 8; ++dt) { acc[dt] = acc[dt] * inv; ss += (acc[dt][0] * acc[dt][0] + acc[dt][1] * acc[dt][1]) + (acc[dt][2] * acc[dt][2] + acc[dt][3] * acc[dt][3]); }
        ss += xor_lane(ss, lane, 16); ss += xor_lane(ss, lane, 32);
        const float rn = 1.0f / sqrtf(ss * (1.0f / MD) + 1e-6f);
        bf16* op = cat + mrow * D + C + h * MD + 4 * g;
#pragma unroll
        for (int dt = 0; dt < 8; ++dt) { const f32x4 gg = *(const f32x4*)(gain + h * MD + 16 * dt + 4 * g);
            u32x2 w; w.x = pk_bf16(acc[dt][0] * rn * gg[0], acc[dt][1] * rn * gg[1]); w.y = pk_bf16(acc[dt][2] * rn * gg[2], acc[dt][3] * rn * gg[3]);
            *(u32x2*)(op + 16 * dt) = w; }
    }
#undef MOBA_LOAD
#undef MOBA_STORE
    __syncthreads();
}

__device__ __forceinline__ void final_phase(const Params& p, const Ctx& c_) {
    const Ctx c = fresh_ctx(c_);
    unsigned char* ws = fresh_ws(p);
    const float* x1 = (const float*)(ws + WS_X1); const bf16* os = (const bf16*)(ws + WS_REG + FX_OSLOT);
    const int* ts = (const int*)(ws + WS_TOKS); const float* tw = (const float*)(ws + WS_TOKW); const float* gain = p.in[47];
    for (int i = 0; i < 4; ++i) {
        const int m = c.wg * 32 + c.wave + 8 * i, b = m / T;
        const float* gt = (const float*)(ws + WS_MOD) + ((size_t)1 * NB + b) * (6 * D) + 5 * D;
        const int s1 = ts[2 * m], s2 = ts[2 * m + 1]; const float w1 = tw[2 * m], w2 = tw[2 * m + 1];
        const f32x4* xr = (const f32x4*)(x1 + (size_t)m * D) + c.lane; const u32x2* o1 = (const u32x2*)(os + (size_t)s1 * D) + c.lane; const u32x2* o2 = (const u32x2*)(os + (size_t)s2 * D) + c.lane;
        const f32x4* gp = (const f32x4*)gt + c.lane;
        f32x4 v[8]; float ss = 0.f;
#pragma unroll
        for (int j = 0; j < 8; ++j) { const u32x2 a = o1[64 * j], bq = o2[64 * j];
            const f32x4 e1 = {bflo(a.x), bfhi(a.x), bflo(a.y), bfhi(a.y)}, e2 = {bflo(bq.x), bfhi(bq.x), bflo(bq.y), bfhi(bq.y)};
            v[j] = xr[64 * j] + gp[64 * j] * (w1 * e1 + w2 * e2); ss += (v[j][0] * v[j][0] + v[j][1] * v[j][1]) + (v[j][2] * v[j][2] + v[j][3] * v[j][3]); }
        ss = wave_sum(ss, c.lane);
        const float rn = 1.0f / sqrtf(ss * (1.0f / D) + 1e-6f);
        f32x4* op = (f32x4*)(p.out + (size_t)m * D) + c.lane;
#pragma unroll
        for (int j = 0; j < 8; ++j) op[64 * j] = v[j] * rn * ((const f32x4*)gain)[c.lane + 64 * j];
    }
}

template <int L>
__device__ __forceinline__ void layer_phases(const Params& p, const Ctx& c, const XcdBarrier& bar, const float* xin) {
    constexpr int PB = L ? 23 : 2, Q = PB + 10 + (L ? 2 : 0);
    unsigned char* ws = fresh_ws(p);
    bf16* hb = (bf16*)(ws + WS_H);
    const float* modl = (const float*)(ws + WS_MOD) + (size_t)L * NB * 6 * D;
    PH(1, norm_mod_phase<L == 0, false>(p, c, xin, p.in[PB + 2], L, 0, hb, nullptr));
    xcd_barrier(bar);
    { pg8::Gemm g{hb, (const bf16*)(ws + WS_WIN) + (size_t)L * NPP * D, M, NPP, D}; pg8::StaticOrder S; S.init(M, NPP, NWG, c.wg);
      pg8::EpiStoreBf16 E{(bf16*)(ws + WS_REG + MX_PROJ), NPP};
      PH(2, pg8::gemm_phase<pg8::EpiStoreBf16, pg8::StaticOrder, true, true>(c.lds, g, S, E, c.wave)); }
    xcd_barrier(bar);
    PH(3, prep_phase<L>(p, c));
    xcd_barrier(bar);
    PH(4, scan_phase<L>(p, c));
    xcd_barrier(bar);
    PH(5, mix_post_phase<L>(p, c));
    PH(11, moba_phase<L>(p, c));
    xcd_barrier(bar);
    { pg8::Gemm g{(const bf16*)(ws + WS_CAT), (const bf16*)(ws + WS_WOUT) + (size_t)L * D * D, M, D, D}; pg8::StaticOrder S; S.init(M, D, NWG, c.wg);
      pg8::EpiResid E{(float*)(ws + WS_X1), xin, modl + 2 * D, D, 6 * D, T / 256};
      PH(6, pg8::gemm_phase<pg8::EpiResid, pg8::StaticOrder, true, true>(c.lds, g, S, E, c.wave)); }
    xcd_barrier(bar);
    norm_mod_phase<false, L == 1>(p, c, (const float*)(ws + WS_X1), p.in[Q + 7], L, 3 * D, hb, L ? p.in[43] : nullptr);
    xcd_barrier(bar);
    if (L == 0) {
        { pg8::Gemm g{hb, (const bf16*)(ws + WS_FGU), M, 2 * FF, D}; pg8::StaticOrder S; S.init(M, 2 * FF, NWG, c.wg);
          pg8::EpiSwiglu E{(bf16*)(ws + WS_REG + FX_ACT), FF, NFT};
          PH(8, pg8::gemm_phase<pg8::EpiSwiglu, pg8::StaticOrder, true, true>(c.lds, g, S, E, c.wave)); }
        xcd_barrier(bar);
        { pg8::Gemm g{(const bf16*)(ws + WS_REG + FX_ACT), (const bf16*)(ws + WS_FD), M, D, FF}; pg8::StaticOrder S; S.init(M, D, NWG, c.wg);
          pg8::EpiResid E{(float*)(ws + WS_X2), (const float*)(ws + WS_X1), modl + 5 * D, D, 6 * D, T / 256};
          PH(9, pg8::gemm_phase<pg8::EpiResid, pg8::StaticOrder, true, true>(c.lds, g, S, E, c.wave)); }
        xcd_barrier(bar);
    } else {
        PH(7, moe_gather_phase(p, c));
        xcd_barrier(bar);
        const LAS int* tb = (const LAS int*)(c.lds + LDSCTL_OFF + 64);
        { pg8::Gemm g{(const bf16*)(ws + WS_REG + FX_AMOE), (const bf16*)(ws + WS_EGU), SLOTS, NE * 2 * FF, D / 2}; pg8::MoeOrder S{tb, NFT, NWG, c.wg};
          pg8::EpiSwigluF8 E{ws + WS_REG + FX_ACT, FF, NFT, 1.0f / (A8_SCALE * W8_SCALE), H8_SCALE};
          PH(8, pg8::gemm_phase<pg8::EpiSwigluF8, pg8::MoeOrder, true, true, true>(c.lds, g, S, E, c.wave)); }
        xcd_barrier(bar);
        { pg8::Gemm g{(const bf16*)(ws + WS_REG + FX_ACT), (const bf16*)(ws + WS_ED), SLOTS, NE * D, FF / 2}; pg8::MoeOrder S{tb, D / 256, NWG, c.wg};
          pg8::EpiStoreBf16S E{(bf16*)(ws + WS_REG + FX_OSLOT), D, D / 256, 1.0f / (H8_SCALE * W8_SCALE)};
          PH(9, pg8::gemm_phase<pg8::EpiStoreBf16S, pg8::MoeOrder, true, true, true>(c.lds, g, S, E, c.wave)); }
        xcd_barrier(bar);
        PH(10, final_phase(p, c));
    }
}

__global__ void __launch_bounds__(512, 2) fwd_kernel(Params p) {
    extern __shared__ __attribute__((aligned(16))) unsigned char lds_raw[];
    Ctx c; c.lds = (LAS unsigned char*)lds_raw; c.wave = __builtin_amdgcn_readfirstlane((int)threadIdx.x >> 6); asm volatile("v_mbcnt_lo_u32_b32 %0, -1, 0\n\tv_mbcnt_hi_u32_b32 %0, -1, %0" : "=v"(c.lane)); c.tid = c.wave * 64 + c.lane; c.wg = blockIdx.x;
    for (int u = c.tid; u < (LDS_BYTES - LDSCTL_OFF) / 4; u += 512) ((LAS unsigned*)(c.lds + LDSCTL_OFF))[u] = 0u;
    __syncthreads();
    const XcdBarrier bar = xcd_barrier_post((unsigned*)(p.ws + WS_CTL) + CW_BAR, (volatile LAS unsigned*)(c.lds + LDSCTL_OFF));
    PH(0, p0_prologue(p, c));
    xcd_barrier(bar);
    layer_phases<0>(p, c, bar, p.in[0]);
    layer_phases<1>(p, c, bar, (const float*)(p.ws + WS_X2));
}
}

extern "C" void kernel_launch(void* const* d_in, const int* in_sizes, int n_in, void* d_out, int out_size, void* d_ws, size_t ws_size, hipStream_t stream) {
    if (n_in != 48 || out_size != M * D || ws_size < WS_END) { fprintf(stderr, "kernel_launch: unexpected problem (n_in %d out %d ws %zu need %zu)\n", n_in, out_size, ws_size, (size_t)WS_END); return; }
    static int ready = 0;
    if (!ready) {
        if (hipFuncSetAttribute((const void*)fwd_kernel, hipFuncAttributeMaxDynamicSharedMemorySize, LDS_BYTES) != hipSuccess) { fprintf(stderr, "kernel_launch: hipFuncSetAttribute failed\n"); return; }
        int per_cu = 0, dev = 0, cus = 0;
        (void)hipGetDevice(&dev); (void)hipDeviceGetAttribute(&cus, hipDeviceAttributeMultiprocessorCount, dev);
        if (hipOccupancyMaxActiveBlocksPerMultiprocessor(&per_cu, (const void*)fwd_kernel, 512, LDS_BYTES) != hipSuccess || per_cu < 1 || cus < NWG) { fprintf(stderr, "kernel_launch: grid of %d workgroups is not resident (per_cu %d, cus %d)\n", NWG, per_cu, cus); return; }
        ready = 1;
    }
    (void)hipMemsetAsync((char*)d_ws + WS_CTL, 0, CTL_BYTES, stream);
    Params p; memset(&p, 0, sizeof(p));
    for (int i = 0; i < 48; ++i) p.in[i] = (const float*)d_in[i];
    p.out = (float*)d_out; p.ws = (unsigned char*)d_ws;
    hipLaunchKernelGGL(fwd_kernel, dim3(NWG), dim3(512), LDS_BYTES, stream, p);
}
```

```cpp
#include <hip/hip_runtime.h>
#include <stdint.h>
#include <string.h>
#include <stdio.h>
namespace pg8 {
#define PG8_LAS __attribute__((address_space(3)))
typedef unsigned short bf16_t;
typedef short bf16x8 __attribute__((ext_vector_type(8)));
typedef float f32x4 __attribute__((ext_vector_type(4)));
typedef unsigned u32x4 __attribute__((ext_vector_type(4)));
constexpr int BM = 256, BK = 64, HALF = 128, HTB = HALF * BK * 2  , STAGE_BYTES = 8 * HTB, NXCD = 8, WGM = 8;

__host__ __device__ __forceinline__ int lds_byte(int r, int c) { const int st = (r >> 4) * 2 + (c >> 5), rr = r & 15, cc = c & 31, ob = rr * 64 + cc * 2; return st * 1024 + (ob ^ (((ob >> 9) & 1) << 5)); }
__host__ __device__ __forceinline__ void stage_rc(int b, int& R, int& C) { const int st = b / 1024, sb = b % 1024, swz = sb ^ (((sb >> 9) & 1) << 5); R = (st >> 1) * 16 + swz / 64; C = (st & 1) * 32 + (swz % 64) / 2; }
__host__ __device__ __forceinline__ int perm32(int rho) { const int n = rho >> 4, i = rho & 15; return 8 * (i >> 2) + 4 * n + (i & 3); }

struct Unit { int pm, pn; };
struct Gemm { const bf16_t* A; const bf16_t* Bt; int M, N, K; };

struct StaticOrder {
    int nM, nN, nwg, G, c;
    __host__ __device__ void init(int M, int N, int G_, int c_) { nM = M / BM; nN = N / BM; nwg = nM * nN; G = G_; c = c_; }
    __host__ __device__ bool next(int i, Unit& u) const {
        const long L = (long)i * G + c; if (L >= nwg) return false;
        int wgid = (int)L; { const int q = nwg / NXCD, r = nwg % NXCD, xcd = wgid % NXCD, off = wgid / NXCD; wgid = (xcd < r ? xcd * (q + 1) : r * (q + 1) + (xcd - r) * q) + off; }
        const int nig = WGM * nN, gid = wgid / nig, fm = gid * WGM, gsz = (nM - fm) < WGM ? (nM - fm) : WGM;
        u.pm = fm + ((wgid % nig) % gsz); u.pn = (wgid % nig) / gsz; return true;
    }
    __device__ __forceinline__ void a_ready(const Unit&) const {}
    __device__ __forceinline__ void done(const Unit&) const {}
};

typedef float f32x2cv_ __attribute__((ext_vector_type(2))); typedef __bf16 bf16x2cv_ __attribute__((ext_vector_type(2)));
__device__ __forceinline__ unsigned cvt_pk_bf16(float lo, float hi) { const f32x2cv_ v = {lo, hi}; const bf16x2cv_ b = __builtin_convertvector(v, bf16x2cv_); return __builtin_bit_cast(unsigned, b); }

__device__ __forceinline__ float silu_f(float x) { return x * __builtin_amdgcn_rcpf(1.0f + __expf(-x)); }
struct EpiStoreBf16 {
    static constexpr bool PERM = true, AFTER_DRAIN = false;
    bf16_t* O; int ldc;
    __device__ __forceinline__ void operator()(const f32x4 (&acc)[2][2][4][2], const Unit& u, int wr, int wc, int fr, int fq) const {
        const int row0 = u.pm * BM + wr * 64 + fr, col0 = u.pn * BM + wc * 32 + 8 * fq;
#pragma unroll
        for (int ai = 0; ai < 2; ++ai)
#pragma unroll
            for (int m = 0; m < 4; ++m) { bf16_t* rowp = O + (size_t)(row0 + ai * HALF + m * 16) * ldc + col0;
#pragma unroll
                for (int bj = 0; bj < 2; ++bj) { const f32x4 v0 = acc[ai][bj][m][0], v1 = acc[ai][bj][m][1];
                    u32x4 w; w.x = cvt_pk_bf16(v0[0], v0[1]); w.y = cvt_pk_bf16(v0[2], v0[3]); w.z = cvt_pk_bf16(v1[0], v1[1]); w.w = cvt_pk_bf16(v1[2], v1[3]);
                    *(u32x4*)(rowp + bj * HALF) = w; } }
    }
};
struct EpiResid {
    static constexpr bool PERM = false, AFTER_DRAIN = false;
    float* C; const float* R; const float* gate; int ldc, gstride, tiles_per_batch;
    __device__ __forceinline__ void operator()(const f32x4 (&acc)[2][2][4][2], const Unit& u, int wr, int wc, int fr, int fq) const {
        const int row0 = u.pm * BM + wr * 64 + fr, col0 = u.pn * BM + wc * 32 + 4 * fq;
        const float* gp = gate + (size_t)(u.pm / tiles_per_batch) * gstride + col0;
        f32x4 gv[2][2];
#pragma unroll
        for (int bj = 0; bj < 2; ++bj)
#pragma unroll
            for (int n = 0; n < 2; ++n) gv[bj][n] = *(const f32x4*)(gp + bj * HALF + n * 16);
#pragma unroll
        for (int ai = 0; ai < 2; ++ai)
#pragma unroll
            for (int m = 0; m < 4; ++m) { const size_t off = (size_t)(row0 + ai * HALF + m * 16) * ldc + col0;
#pragma unroll
                for (int bj = 0; bj < 2; ++bj)
#pragma unroll
                    for (int n = 0; n < 2; ++n) { const f32x4 r = *(const f32x4*)(R + off + bj * HALF + n * 16); *(f32x4*)(C + off + bj * HALF + n * 16) = r + gv[bj][n] * acc[ai][bj][m][n]; } }
    }
};
struct EpiSwiglu {
    static constexpr bool PERM = true, AFTER_DRAIN = false;
    bf16_t* O; int ldc, nN;
    __device__ __forceinline__ void operator()(const f32x4 (&acc)[2][2][4][2], const Unit& u, int wr, int wc, int fr, int fq) const {
        const int row0 = u.pm * BM + wr * 64 + fr, col0 = (u.pn % nN) * HALF + wc * 32 + 8 * fq;
#pragma unroll
        for (int ai = 0; ai < 2; ++ai)
#pragma unroll
            for (int m = 0; m < 4; ++m) {
                const f32x4 g0 = acc[ai][0][m][0], g1 = acc[ai][0][m][1], u0 = acc[ai][1][m][0], u1 = acc[ai][1][m][1];
                u32x4 w;
                w.x = cvt_pk_bf16(silu_f(g0[0]) * u0[0], silu_f(g0[1]) * u0[1]); w.y = cvt_pk_bf16(silu_f(g0[2]) * u0[2], silu_f(g0[3]) * u0[3]);
                w.z = cvt_pk_bf16(silu_f(g1[0]) * u1[0], silu_f(g1[1]) * u1[1]); w.w = cvt_pk_bf16(silu_f(g1[2]) * u1[2], silu_f(g1[3]) * u1[3]);
                *(u32x4*)(O + (size_t)(row0 + ai * HALF + m * 16) * ldc + col0) = w; }
    }
};
struct EpiStoreF32 {
    static constexpr bool PERM = false, AFTER_DRAIN = false;
    float* C; int ldc, nN;
    __device__ __forceinline__ void operator()(const f32x4 (&acc)[2][2][4][2], const Unit& u, int wr, int wc, int fr, int fq) const {
        const int row0 = u.pm * BM + wr * 64 + fr, col0 = (u.pn % nN) * BM + wc * 32 + 4 * fq;
#pragma unroll
        for (int ai = 0; ai < 2; ++ai)
#pragma unroll
            for (int m = 0; m < 4; ++m) { float* rowp = C + (size_t)(row0 + ai * HALF + m * 16) * ldc + col0;
#pragma unroll
                for (int bj = 0; bj < 2; ++bj)
#pragma unroll
                    for (int n = 0; n < 2; ++n) *(f32x4*)(rowp + bj * HALF + n * 16) = acc[ai][bj][m][n]; }
    }
};
__device__ __forceinline__ unsigned pk4_fp8(float a, float b, float c, float d) { int w = 0; w = __builtin_amdgcn_cvt_pk_fp8_f32(a, b, w, false); w = __builtin_amdgcn_cvt_pk_fp8_f32(c, d, w, true); return (unsigned)w; }
__device__ __forceinline__ float sat8(float x) { return __builtin_amdgcn_fmed3f(x, -448.0f, 448.0f); }
__device__ __forceinline__ unsigned pk4_fp8_sat(float a, float b, float c, float d) { return pk4_fp8(sat8(a), sat8(b), sat8(c), sat8(d)); }
struct EpiSwigluF8 {
    static constexpr bool PERM = true, AFTER_DRAIN = false;
    unsigned char* O; int ldc, nN; float sin, sout;
    __device__ __forceinline__ void operator()(const f32x4 (&acc)[2][2][4][2], const Unit& u, int wr, int wc, int fr, int fq) const {
        const int row0 = u.pm * BM + wr * 64 + fr, col0 = (u.pn % nN) * HALF + wc * 32 + 8 * fq;
        typedef unsigned u32x2_ __attribute__((ext_vector_type(2)));
#pragma unroll
        for (int ai = 0; ai < 2; ++ai)
#pragma unroll
            for (int m = 0; m < 4; ++m) {
                const f32x4 g0 = acc[ai][0][m][0] * sin, g1 = acc[ai][0][m][1] * sin, u0 = acc[ai][1][m][0] * (sin * sout), u1 = acc[ai][1][m][1] * (sin * sout);
                u32x2_ w;
                w.x = pk4_fp8_sat(silu_f(g0[0]) * u0[0], silu_f(g0[1]) * u0[1], silu_f(g0[2]) * u0[2], silu_f(g0[3]) * u0[3]);
                w.y = pk4_fp8_sat(silu_f(g1[0]) * u1[0], silu_f(g1[1]) * u1[1], silu_f(g1[2]) * u1[2], silu_f(g1[3]) * u1[3]);
                *(u32x2_*)(O + (size_t)(row0 + ai * HALF + m * 16) * ldc + col0) = w; }
    }
};
struct EpiStoreF32S {
    static constexpr bool PERM = false, AFTER_DRAIN = false;
    float* C; int ldc, nN; float s;
    __device__ __forceinline__ void operator()(const f32x4 (&acc)[2][2][4][2], const Unit& u, int wr, int wc, int fr, int fq) const {
        const int row0 = u.pm * BM + wr * 64 + fr, col0 = (u.pn % nN) * BM + wc * 32 + 4 * fq;
#pragma unroll
        for (int ai = 0; ai < 2; ++ai)
#pragma unroll
            for (int m = 0; m < 4; ++m) { float* rowp = C + (size_t)(row0 + ai * HALF + m * 16) * ldc + col0;
#pragma unroll
                for (int bj = 0; bj < 2; ++bj)
#pragma unroll
                    for (int n = 0; n < 2; ++n) *(f32x4*)(rowp + bj * HALF + n * 16) = acc[ai][bj][m][n] * s; }
    }
};
struct EpiStoreBf16S {
    static constexpr bool PERM = true, AFTER_DRAIN = false;
    bf16_t* O; int ldc, nN; float s;
    __device__ __forceinline__ void operator()(const f32x4 (&acc)[2][2][4][2], const Unit& u, int wr, int wc, int fr, int fq) const {
        const int row0 = u.pm * BM + wr * 64 + fr, col0 = (u.pn % nN) * BM + wc * 32 + 8 * fq;
#pragma unroll
        for (int ai = 0; ai < 2; ++ai)
#pragma unroll
            for (int m = 0; m < 4; ++m) { bf16_t* rowp = O + (size_t)(row0 + ai * HALF + m * 16) * ldc + col0;
#pragma unroll
                for (int bj = 0; bj < 2; ++bj) { const f32x4 v0 = acc[ai][bj][m][0] * s, v1 = acc[ai][bj][m][1] * s;
                    u32x4 w; w.x = cvt_pk_bf16(v0[0], v0[1]); w.y = cvt_pk_bf16(v0[2], v0[3]); w.z = cvt_pk_bf16(v1[0], v1[1]); w.w = cvt_pk_bf16(v1[2], v1[3]);
                    *(u32x4*)(rowp + bj * HALF) = w; } }
    }
};
struct MoeOrder {
    const PG8_LAS int* tb; int nN, G, c;
    __device__ __forceinline__ bool next(int i, Unit& u) const {
        const int L = i * G + ((c & 7) * (G >> 3) + (c >> 3)); if (L >= tb[8] * nN) return false;
        int e = 0;
#pragma unroll
        for (int q = 1; q < 8; ++q) if (L >= tb[q] * nN) e = q;
        const int t0 = tb[e], rt = tb[e + 1] - t0, idx = L - t0 * nN;
        u.pm = t0 + idx % rt; u.pn = e * nN + idx / rt; return true;
    }
    __device__ __forceinline__ void a_ready(const Unit&) const {}
    __device__ __forceinline__ void done(const Unit&) const {}
};


template <class Epi, class Sched, bool ALIGN_EPI = false, bool SP2 = false, bool FP8 = false>
__device__ __forceinline__ void gemm_phase(PG8_LAS unsigned char* lds, const Gemm g, const Sched& S, const Epi& E, const int wave_id) {
    int lane_; asm volatile("v_mbcnt_lo_u32_b32 %0, -1, 0\n\tv_mbcnt_hi_u32_b32 %0, -1, %0" : "=v"(lane_));
    const int wid = wave_id, lane = lane_, tid = wid * 64 + lane, wr = wid >> 2, wc = wid & 3, fr = lane & 15, fq = lane >> 4;
    const int K = g.K, nt = K / BK;
    unsigned voffA[2], voffB[2];
#pragma unroll
    for (int i = 0; i < 2; ++i) { int R, C; stage_rc(tid * 16 + i * 8192, R, C); const int Rb = Epi::PERM ? ((R & ~31) + perm32(R & 31)) : R;
        voffA[i] = (unsigned)(R * K + C) * 2u; voffB[i] = (unsigned)(Rb * K + C) * 2u; }
    const size_t kstep = (size_t)(BK * 2);
    const size_t hstep = (size_t)HALF * K * 2;
    const size_t tstep = 2 * hstep;
    const unsigned ldsw = (unsigned)wid * 1024u;
    const int aoff = lds_byte(wr * 64 + fr, fq * 8), boff = lds_byte(wc * 32 + fr, fq * 8);
#define PG8_SA(b, h) (((b) * 2 + (h)) * HTB)
#define PG8_SB(b, h) ((4 + (b) * 2 + (h)) * HTB)
#define PG8_STAGE(bufoff, gbase, voff) do { _Pragma("unroll") for (int _i = 0; _i < 2; ++_i) \
        __builtin_amdgcn_global_load_lds((const unsigned*)((const char*)(gbase) + (voff)[_i]), (PG8_LAS unsigned*)(lds + (bufoff) + ldsw + _i * 8192), 16, 0, 0); } while (0)
#define PG8_LDA(dst, b, h) do { _Pragma("unroll") for (int m = 0; m < 4; ++m) _Pragma("unroll") for (int k = 0; k < 2; ++k) dst[m][k] = *(const PG8_LAS bf16x8*)(lds + PG8_SA(b, h) + aoff + m * 2048 + k * 1024); } while (0)
#define PG8_LDB(dst, b, h) do { _Pragma("unroll") for (int n = 0; n < 2; ++n) _Pragma("unroll") for (int k = 0; k < 2; ++k) dst[n][k] = *(const PG8_LAS bf16x8*)(lds + PG8_SB(b, h) + boff + n * 2048 + k * 1024); } while (0)
#define PG8_MMA(ai, bj, At, Bt) do { __builtin_amdgcn_s_setprio(1); _Pragma("unroll") for (int m = 0; m < 4; ++m) _Pragma("unroll") for (int n = 0; n < 2; ++n) { \
        if constexpr (FP8) { typedef int i32x4_ __attribute__((ext_vector_type(4))); typedef int i32x8_ __attribute__((ext_vector_type(8))); \
            const i32x8_ b8_ = __builtin_shufflevector(__builtin_bit_cast(i32x4_, Bt[n][0]), __builtin_bit_cast(i32x4_, Bt[n][1]), 0, 1, 2, 3, 4, 5, 6, 7); \
            const i32x8_ a8_ = __builtin_shufflevector(__builtin_bit_cast(i32x4_, At[m][0]), __builtin_bit_cast(i32x4_, At[m][1]), 0, 1, 2, 3, 4, 5, 6, 7); \
            asm volatile("v_mfma_scale_f32_16x16x128_f8f6f4 %0, %1, %2, %0, %3, %3 op_sel_hi:[0,0,0]" : "+v"(acc[ai][bj][m][n]) : "v"(b8_), "v"(a8_), "v"(one8_)); } \
        else { _Pragma("unroll") for (int k = 0; k < 2; ++k) acc[ai][bj][m][n] = __builtin_amdgcn_mfma_f32_16x16x32_bf16(Bt[n][k], At[m][k], acc[ai][bj][m][n], 0, 0, 0); } } \
        __builtin_amdgcn_s_setprio(0); } while (0)
#define PG8_WAIT_V(n) asm volatile("s_waitcnt vmcnt(" #n ")" ::: "memory")
#define PG8_WAIT_L(n) asm volatile("s_waitcnt lgkmcnt(" #n ")" ::: "memory")
#define PG8_BAR __builtin_amdgcn_s_barrier()
#define PG8_SCHED __builtin_amdgcn_sched_barrier(0)
    const int one8_ = 0x7F7F7F7F;
    Unit cur, nxt; int ui = 0;
    if (!S.next(0, cur)) return;
    f32x4 acc[2][2][4][2];
#pragma unroll
    for (int a = 0; a < 2; ++a)
#pragma unroll
        for (int b = 0; b < 2; ++b)
#pragma unroll
            for (int m = 0; m < 4; ++m)
#pragma unroll
                for (int n = 0; n < 2; ++n) acc[a][b][m][n] = (f32x4){0.f, 0.f, 0.f, 0.f};
    bf16x8 At[4][2], B0[2][2], B1[2][2];
    const char* cA = (const char*)g.A + (size_t)cur.pm * tstep; const char* cB = (const char*)g.Bt + (size_t)cur.pn * tstep;
    S.a_ready(cur);
    if constexpr (SP2) {
        PG8_STAGE(PG8_SB(0, 0), cB, voffB); PG8_STAGE(PG8_SB(0, 1), cB + hstep, voffB); PG8_STAGE(PG8_SA(0, 0), cA, voffA); PG8_STAGE(PG8_SA(0, 1), cA + hstep, voffA);
        if (wr == 1) PG8_BAR;
        PG8_WAIT_V(2); PG8_BAR;
        PG8_STAGE(PG8_SB(1, 0), cB + kstep, voffB); PG8_STAGE(PG8_SA(1, 0), cA + kstep, voffA); PG8_STAGE(PG8_SB(1, 1), cB + hstep + kstep, voffB);
        PG8_WAIT_V(6); PG8_BAR;
    } else {
        PG8_STAGE(PG8_SB(0, 0), cB, voffB); PG8_STAGE(PG8_SA(0, 0), cA, voffA); PG8_STAGE(PG8_SB(0, 1), cB + hstep, voffB); PG8_STAGE(PG8_SA(0, 1), cA + hstep, voffA);
        if (wr == 1) PG8_BAR;
        PG8_WAIT_V(4); PG8_BAR;
        PG8_STAGE(PG8_SB(1, 0), cB + kstep, voffB); PG8_STAGE(PG8_SA(1, 0), cA + kstep, voffA); PG8_STAGE(PG8_SB(1, 1), cB + hstep + kstep, voffB);
        PG8_WAIT_V(6); PG8_BAR;
    }
    for (;;) {
        const bool has_next = S.next(ui + 1, nxt);
        const char* nA = has_next ? (const char*)g.A + (size_t)nxt.pm * tstep : cA; const char* nB = has_next ? (const char*)g.Bt + (size_t)nxt.pn * tstep : cB;
        for (int t = 0; t < nt; t += 2) {
            const bool last = (t == nt - 2);
            const char* a1 = cA + (size_t)(t + 1) * kstep;
            const char* a2 = last ? nA : cA + (size_t)(t + 2) * kstep; const char* b2 = last ? nB : cB + (size_t)(t + 2) * kstep;
            const char* a3 = a2 + kstep; const char* b3 = b2 + kstep;
            if (last && has_next) S.a_ready(nxt);
            if constexpr (SP2) {
            PG8_LDB(B0, 0, 0); PG8_LDB(B1, 0, 1); PG8_SCHED; PG8_LDA(At, 0, 0); PG8_STAGE(PG8_SA(1, 1), a1 + hstep, voffA);
            PG8_WAIT_V(8); PG8_WAIT_L(0); PG8_BAR; PG8_MMA(0, 0, At, B0); PG8_MMA(0, 1, At, B1); PG8_BAR; PG8_SCHED;
            PG8_LDA(At, 0, 1); PG8_STAGE(PG8_SB(0, 0), b2, voffB); PG8_STAGE(PG8_SB(0, 1), b2 + hstep, voffB); PG8_STAGE(PG8_SA(0, 0), a2, voffA);
            PG8_WAIT_V(8); PG8_WAIT_L(0); PG8_BAR; PG8_MMA(1, 0, At, B0); PG8_MMA(1, 1, At, B1); PG8_BAR; PG8_SCHED;
            PG8_LDB(B0, 1, 0); PG8_LDB(B1, 1, 1); PG8_SCHED; PG8_LDA(At, 1, 0); PG8_STAGE(PG8_SA(0, 1), a2 + hstep, voffA);
            PG8_WAIT_V(8); PG8_WAIT_L(0); PG8_BAR; PG8_MMA(0, 0, At, B0); PG8_MMA(0, 1, At, B1); PG8_BAR; PG8_SCHED;
            PG8_LDA(At, 1, 1); PG8_STAGE(PG8_SB(1, 0), b3, voffB); PG8_STAGE(PG8_SB(1, 1), b3 + hstep, voffB); PG8_STAGE(PG8_SA(1, 0), a3, voffA);
            PG8_WAIT_V(8); PG8_WAIT_L(0); PG8_BAR; PG8_MMA(1, 0, At, B0); PG8_MMA(1, 1, At, B1); PG8_BAR; PG8_SCHED;
            } else {
            PG8_LDB(B0, 0, 0); PG8_SCHED; PG8_LDA(At, 0, 0); PG8_STAGE(PG8_SA(1, 1), a1 + hstep, voffA);
            PG8_WAIT_L(8); PG8_BAR; PG8_WAIT_L(0); PG8_MMA(0, 0, At, B0); PG8_BAR; PG8_SCHED;
            PG8_LDB(B1, 0, 1); PG8_STAGE(PG8_SB(0, 0), b2, voffB);
            PG8_BAR; PG8_WAIT_L(0); PG8_MMA(0, 1, At, B1); PG8_BAR;
            PG8_LDA(At, 0, 1); PG8_STAGE(PG8_SA(0, 0), a2, voffA);
            PG8_BAR; PG8_WAIT_L(0); PG8_MMA(1, 0, At, B0); PG8_BAR; PG8_SCHED;
            PG8_STAGE(PG8_SB(0, 1), b2 + hstep, voffB);
            PG8_WAIT_V(6); PG8_BAR; PG8_MMA(1, 1, At, B1); PG8_BAR;
            PG8_LDB(B0, 1, 0); PG8_SCHED; PG8_LDA(At, 1, 0); PG8_STAGE(PG8_SA(0, 1), a2 + hstep, voffA);
            PG8_WAIT_L(8); PG8_BAR; PG8_WAIT_L(0); PG8_MMA(0, 0, At, B0); PG8_BAR; PG8_SCHED;
            PG8_LDB(B1, 1, 1); PG8_STAGE(PG8_SB(1, 0), b3, voffB);
            PG8_BAR; PG8_WAIT_L(0); PG8_MMA(0, 1, At, B1); PG8_BAR;
            PG8_LDA(At, 1, 1); PG8_STAGE(PG8_SA(1, 0), a3, voffA);
            PG8_BAR; PG8_WAIT_L(0); PG8_MMA(1, 0, At, B0); PG8_BAR; PG8_SCHED;
            PG8_STAGE(PG8_SB(1, 1), b3 + hstep, voffB);
            PG8_WAIT_V(6); PG8_BAR; PG8_MMA(1, 1, At, B1); PG8_BAR;
            }
        }
        if constexpr (FP8) asm volatile("s_nop 15\n\ts_nop 15" ::: "memory");
        if constexpr (ALIGN_EPI) { if (wr == 0) PG8_BAR; }
        if constexpr (!Epi::AFTER_DRAIN) { E(acc, cur, wr, wc, fr, fq); S.done(cur); }
        if (!has_next) break;
#pragma unroll
        for (int a = 0; a < 2; ++a)
#pragma unroll
            for (int b = 0; b < 2; ++b)
#pragma unroll
                for (int m = 0; m < 4; ++m)
#pragma unroll
                    for (int n = 0; n < 2; ++n) acc[a][b][m][n] = (f32x4){0.f, 0.f, 0.f, 0.f};
        cur = nxt; cA = nA; cB = nB; ++ui;
        if constexpr (ALIGN_EPI) { if (wr == 1) PG8_BAR; }
    }
    PG8_WAIT_V(0);
    if constexpr (!ALIGN_EPI) { if (wr == 0) PG8_BAR; }
    PG8_BAR;
    if constexpr (Epi::AFTER_DRAIN) { E.fused(acc, cur, wr, wc, fr, fq, lds, wid, lane); S.done(cur); }
#undef PG8_SA
#undef PG8_SB
#undef PG8_STAGE
#undef PG8_LDA
#undef PG8_LDB
#undef PG8_MMA
#undef PG8_WAIT_V
#undef PG8_WAIT_L
#undef PG8_BAR
#undef PG8_SCHED
}
}

#define LAS __attribute__((address_space(3)))
#define XB_TMO      128
#define XB_XCNT(j)  (256  + 64 * (j))
#define XB_XSUB(j)  (1280 + 64 * (j))
#define XB_XGEN(j)  (2304 + 64 * (j))
#define XB_TOP      3328
#define XB_TOPGEN   3392
#define XCD_BAR_WORDS 3456
#define XB_SPIN_CAP (1u << 18)

__device__ __forceinline__ unsigned xb_ld(unsigned* p)              { return __hip_atomic_load(p, __ATOMIC_RELAXED, __HIP_MEMORY_SCOPE_AGENT); }
__device__ __forceinline__ unsigned xb_add(unsigned* p, unsigned v) { return __hip_atomic_fetch_add(p, v, __ATOMIC_RELAXED, __HIP_MEMORY_SCOPE_AGENT); }
__device__ __forceinline__ unsigned xb_xcc_id() { return (unsigned)__builtin_amdgcn_s_getreg((3 << 11) | 20) & 0xFu; }
#define XB_SPIN(cond, bar) do { unsigned _sp = 0; while (cond) { __builtin_amdgcn_s_sleep(1); \
    if ((++_sp & 255u) == 0u) { if (xb_ld(&(bar)[XB_TMO])) break; if (_sp > XB_SPIN_CAP) { atomicAdd(&(bar)[XB_TMO], 1u); break; } } } } while (0)

struct XcdBarrier {
    unsigned* bar; unsigned x;
    volatile LAS unsigned* st;
};

__device__ __forceinline__ XcdBarrier xcd_barrier_post(unsigned* bar, volatile LAS unsigned* st) {
    XcdBarrier b; b.bar = bar; b.x = xb_xcc_id(); b.st = st;
    if (threadIdx.x == 0) (void)xb_add(&bar[XB_XCNT(b.x)], 1u);
    return b;
}
__device__ __forceinline__ void xcd_barrier_complete(unsigned* bar, unsigned x, unsigned& nloc, unsigned& nx) {
    const unsigned G = gridDim.x * gridDim.y * gridDim.z;
    unsigned sum, cnt, mine, sp = 0u;
    for (;;) {
        sum = 0u; cnt = 0u; mine = 0u;
#pragma unroll
        for (unsigned j = 0; j < 16; ++j) { const unsigned c = xb_ld(&bar[XB_XCNT(j)]); sum += c; cnt += (c > 0u) ? 1u : 0u; mine = (j == x) ? c : mine; }
        if (sum == G) break;
        __builtin_amdgcn_s_sleep(1);
        if ((++sp & 255u) == 0u) { if (xb_ld(&bar[XB_TMO])) break; if (sp > XB_SPIN_CAP) { atomicAdd(&bar[XB_TMO], 1u); break; } }
    }
    nloc = mine > 0u ? mine : 1u; nx = cnt > 0u ? cnt : 1u;
}

__device__ __forceinline__ void xcd_barrier(const XcdBarrier& b) {
    asm volatile("s_waitcnt vmcnt(0)" ::: "memory");
    __syncthreads();
    if (threadIdx.x == 0) {
        unsigned* bar = b.bar;
        __builtin_amdgcn_s_waitcnt(0);
        unsigned nloc = b.st[0], nx = b.st[1];
        if (nloc == 0u) { xcd_barrier_complete(bar, b.x, nloc, nx); b.st[0] = nloc; b.st[1] = nx; }
        const unsigned old = xb_add(&bar[XB_XSUB(b.x)], 1u);
        const unsigned gen = old / nloc;
        if (old + 1u == (gen + 1u) * nloc) {
            __builtin_amdgcn_fence(__ATOMIC_RELEASE, "agent");
            asm volatile("s_waitcnt vmcnt(0)" ::: "memory");
            const unsigned og = xb_add(&bar[XB_TOP], 1u);
            const unsigned tg = og / nx;
            if (og + 1u == (tg + 1u) * nx) xb_add(&bar[XB_TOPGEN], 1u);
            else XB_SPIN(xb_ld(&bar[XB_TOPGEN]) == tg, bar);
            __builtin_amdgcn_fence(__ATOMIC_ACQUIRE, "agent");
            xb_add(&bar[XB_XGEN(b.x)], 1u);
            asm volatile("s_waitcnt vmcnt(0)" ::: "memory");
        } else {
            XB_SPIN(xb_ld(&bar[XB_XGEN(b.x)]) == gen, bar);
            __builtin_amdgcn_fence(__ATOMIC_ACQUIRE, "agent");
            asm volatile("s_waitcnt vmcnt(0)" ::: "memory");
        }
    }
    __syncthreads();
}

#ifndef REP_PHASE
#define REP_PHASE -1
#endif
#ifndef REP_N
#define REP_N 1
#endif
#define PH(k, ...) do { __VA_ARGS__; if (REP_PHASE == (k)) { for (int rn_ = 0; rn_ < REP_N; ++rn_) { xcd_barrier(bar); __VA_ARGS__; } } } while (0)
namespace {
typedef unsigned short bf16;
typedef float f32x4 __attribute__((ext_vector_type(4)));
typedef float f32x2 __attribute__((ext_vector_type(2)));
typedef unsigned u32x4 __attribute__((ext_vector_type(4)));
typedef unsigned u32x2 __attribute__((ext_vector_type(2)));
typedef short bf16x8 __attribute__((ext_vector_type(8)));
constexpr int D = 2048, NB = 4, T = 2048, M = NB * T, C = 1024, H = 16, HN = 64;
constexpr int NR0 = 3360, NR1 = 3392, NP0 = NR0 + 3072, NP1 = NR1 + 3072, NPP = 6656;
constexpr int MH = 8, MD = 128, MBS = 256, NBLK = 8;
constexpr int FF = 5632, NE = 8, NFT = FF / 128;
constexpr int SLOTS = 2 * M + NE * 256;
constexpr int NWG = 256, NWAVE = 8, NGW = NWG * NWAVE;
constexpr int KSPLIT = 8;
constexpr int RING_BYTES = 131072, LDSCTL_OFF = RING_BYTES, LDS_BYTES = RING_BYTES + 1024;
constexpr size_t al(size_t x) { return (x + 4095) / 4096 * 4096; }
constexpr size_t WS_CTL = 0, CTL_BYTES = 1u << 20;
constexpr int CW_BAR = 1024, CW_CNT = 8192;
constexpr size_t WS_MODP = WS_CTL + CTL_BYTES;
constexpr size_t WS_MOD = WS_MODP + al((size_t)KSPLIT * 2 * NB * 6 * D * 4);
constexpr size_t WS_TOKE = WS_MOD + al((size_t)2 * NB * 6 * D * 4);
constexpr size_t WS_TOKP = WS_TOKE + al((size_t)2 * M * 4);
constexpr size_t WS_TOKW = WS_TOKP + al((size_t)2 * M * 4);
constexpr size_t WS_TOKS = WS_TOKW + al((size_t)2 * M * 4);
constexpr size_t WS_KMEAN = WS_TOKS + al((size_t)2 * M * 4);
constexpr size_t WS_RKB = WS_KMEAN + al((size_t)NB * MH * NBLK * MD * 4);
constexpr size_t WS_LW = WS_RKB + al((size_t)M * H * 4);
constexpr size_t WS_WIN = WS_LW + al((size_t)2 * C * 320 * 2);
constexpr size_t WS_WOUT = WS_WIN + al((size_t)2 * NPP * D * 2);
constexpr size_t WS_FGU = WS_WOUT + al((size_t)2 * D * D * 2);
constexpr size_t WS_FD = WS_FGU + al((size_t)2 * FF * D * 2);
constexpr size_t WS_EGU = WS_FD + al((size_t)D * FF * 2);
constexpr size_t WS_ED = WS_EGU + al((size_t)NE * 2 * FF * D * 2);
constexpr size_t WS_H = WS_ED + al((size_t)NE * D * FF * 2);
constexpr size_t WS_X1 = WS_H + al((size_t)M * D * 2);
constexpr size_t WS_X2 = WS_X1 + al((size_t)M * D * 4);
constexpr size_t WS_VF = WS_X2 + al((size_t)M * D * 4);
constexpr size_t WS_CAT = WS_VF + al((size_t)M * C * 4);
constexpr size_t WS_REG = WS_CAT + al((size_t)M * D * 2);
constexpr size_t MX_PROJ = 0;
constexpr size_t MX_SR = MX_PROJ + al((size_t)M * NPP * 2);
constexpr size_t SARR = al((size_t)M * C * 4);
constexpr size_t MX_SIN = MX_SR;
constexpr size_t MX_SV = MX_SIN + al((size_t)M * H * 320 * 4), MX_SG = MX_SV + SARR, MX_SY = MX_SG + SARR, MX_VT = MX_SY + SARR, MX_END = MX_VT + al((size_t)M * C * 2);
constexpr size_t FX_ACT = 0;
constexpr size_t FX_AMOE = FX_ACT + al((size_t)SLOTS * FF * 2);
constexpr size_t FX_OSLOT = FX_AMOE + al((size_t)SLOTS * D * 2);
constexpr size_t FX_END = FX_OSLOT + al((size_t)SLOTS * D * 4);
constexpr size_t WS_END = WS_REG + (MX_END > FX_END ? MX_END : FX_END);

struct Params { const float* in[48]; float* out; unsigned char* ws; };

template <int CTRL> __device__ __forceinline__ float dpp_mov(float v) { return __int_as_float(__builtin_amdgcn_update_dpp(0, __float_as_int(v), CTRL, 0xF, 0xF, true)); }
__device__ __forceinline__ float row16_sum(float v) {
    v += dpp_mov<0xB1>(v);
    v += dpp_mov<0x4E>(v);
    v += dpp_mov<0x141>(v);
    v += dpp_mov<0x140>(v);
    return v;
}
__device__ __forceinline__ float xor_lane(float v, int lane, int m) { return __int_as_float(__builtin_amdgcn_ds_bpermute((lane ^ m) << 2, __float_as_int(v))); }
__device__ __forceinline__ float wave_sum(float v, int lane) { v = row16_sum(v); v += xor_lane(v, lane, 16); v += xor_lane(v, lane, 32); return v; }
__device__ __forceinline__ float bf2f(bf16 b) { return __uint_as_float(((unsigned)b) << 16); }
__device__ __forceinline__ float bflo(unsigned w) { return __uint_as_float(w << 16); }
__device__ __forceinline__ float bfhi(unsigned w) { return __uint_as_float(w & 0xffff0000u); }
__device__ __forceinline__ unsigned pk_bf16(float lo, float hi) { return pg8::cvt_pk_bf16(lo, hi); }
__device__ __forceinline__ float sigmoid_f(float x) { return __builtin_amdgcn_rcpf(1.0f + __expf(-x)); }
#define LDS_WAIT() asm volatile("s_waitcnt lgkmcnt(0)" ::: "memory")

struct Ctx { LAS unsigned char* lds; int tid, lane, wave, wg; };
__device__ __forceinline__ Ctx fresh_ctx(const Ctx& a) {
    Ctx c; int ln, w = a.wg; asm volatile("v_mbcnt_lo_u32_b32 %0, -1, 0\n\tv_mbcnt_hi_u32_b32 %0, -1, %0" : "=v"(ln)); asm volatile("" : "+v"(w));
    c.lds = a.lds; c.lane = ln; c.wave = a.wave; c.tid = a.wave * 64 + ln; c.wg = __builtin_amdgcn_readfirstlane(w); return c;
}
__device__ __forceinline__ unsigned char* fresh_ws(const struct Params& p);

__device__ __forceinline__ unsigned char* fresh_ws(const Params& p) {
    unsigned z = 0u; asm volatile("" : "+v"(z));
    return p.ws + (size_t)__builtin_amdgcn_readfirstlane(z);
}
__device__ __forceinline__ void p0_mod_item(const Params& p, const Ctx& c, int it, LAS float* scr) {
    const int ks = it % KSPLIT, cg = (it / KSPLIT) % 192, l = it / (KSPLIT * 192);
    const float* cc = p.in[1]; const float* mw = p.in[l ? 23 : 2];
    const int k0 = ks * 256;
#pragma unroll
    for (int b = 0; b < NB; ++b)
#pragma unroll
        for (int i = 0; i < 4; ++i) { const float v = cc[b * D + k0 + c.lane + 64 * i]; scr[(c.lane + 64 * i) * 4 + b] = v / (1.0f + __expf(-v)); }
    LDS_WAIT(); asm volatile("" ::: "memory");
    float a0 = 0.f, a1 = 0.f, a2 = 0.f, a3 = 0.f;
    const float* wp = mw + (size_t)k0 * (6 * D) + cg * 64 + c.lane;
#pragma unroll 16
    for (int k = 0; k < 256; ++k) { const float w = wp[(size_t)k * (6 * D)]; const f32x4 cv = *(const LAS f32x4*)(scr + 4 * k); a0 += cv[0] * w; a1 += cv[1] * w; a2 += cv[2] * w; a3 += cv[3] * w; }
    float* o = (float*)(p.ws + WS_MODP) + ((size_t)(ks * 2 + l) * NB) * (6 * D) + cg * 64 + c.lane;
    o[0] = a0; o[6 * D] = a1; o[2 * 6 * D] = a2; o[3 * 6 * D] = a3;
    LDS_WAIT(); asm volatile("" ::: "memory");
}
struct ConvJob { const float* src; unsigned char* dst; int K, N, kt, nt, dst_row0, f8; };
constexpr float W8_SCALE = 256.0f, A8_SCALE = 16.0f, H8_SCALE = 8.0f;
__device__ __forceinline__ void conv_issue(const ConvJob& j, f32x2 (&cv)[32], int lane) {
    const int n = j.nt * 64 + 2 * (lane & 31); const bool ok = n < j.N;
    const float* s = j.src + (size_t)(j.kt * 64 + 32 * (lane >> 5)) * j.N + (ok ? n : 0);
#pragma unroll
    for (int i = 0; i < 32; ++i) cv[i] = *(const f32x2*)(s + (size_t)i * j.N);
}
__device__ __forceinline__ void conv_finish(const ConvJob& j, f32x2 (&cv)[32], LAS unsigned* scr, int lane) {
    const int n2 = lane & 31, kh = lane >> 5; const bool ok = j.nt * 64 + 2 * n2 < j.N;
    if (j.f8) {
#pragma unroll
        for (int q = 0; q < 2; ++q)
#pragma unroll
            for (int i4 = 0; i4 < 8; ++i4) scr[(2 * n2 + q) * 17 + 8 * kh + i4] = pg8::pk4_fp8(cv[4 * i4][q] * W8_SCALE, cv[4 * i4 + 1][q] * W8_SCALE, cv[4 * i4 + 2][q] * W8_SCALE, cv[4 * i4 + 3][q] * W8_SCALE);
        LDS_WAIT(); asm volatile("" ::: "memory");
        const int cch = lane & 3;
#pragma unroll
        for (int jj = 0; jj < 4; ++jj) { const int nn = (lane >> 2) + 16 * jj; const LAS unsigned* qp = scr + nn * 17 + 4 * cch;
            u32x4 o; o.x = qp[0]; o.y = qp[1]; o.z = qp[2]; o.w = qp[3];
            *(u32x4*)(j.dst + (size_t)(j.dst_row0 + nn) * j.K + j.kt * 64 + 16 * cch) = o; }
    } else {
#pragma unroll
        for (int q = 0; q < 2; ++q)
#pragma unroll
            for (int i2 = 0; i2 < 16; ++i2) scr[(2 * n2 + q) * 33 + 16 * kh + i2] = ok ? pk_bf16(cv[2 * i2][q], cv[2 * i2 + 1][q]) : 0u;
        LDS_WAIT(); asm volatile("" ::: "memory");
        const int cch = lane & 7;
#pragma unroll
        for (int jj = 0; jj < 8; ++jj) { const int nn = (lane >> 3) + 8 * jj; const LAS unsigned* qp = scr + nn * 33 + 4 * cch;
            u32x4 o; o.x = qp[0]; o.y = qp[1]; o.z = qp[2]; o.w = qp[3];
            *(u32x4*)(j.dst + ((size_t)(j.dst_row0 + nn) * j.K + j.kt * 64 + 8 * cch) * 2) = o; }
    }
    LDS_WAIT(); asm volatile("" ::: "memory");
}
__device__ __forceinline__ int gu_row(int n) { return (n >> 7) * 256 + (n & 127); }
constexpr int I_MOD = 2 * 192 * KSPLIT;
constexpr int I_WIN = (NPP / 64) * (D / 64), I_WOUT = (D / 64) * (D / 64), I_FG = (FF / 64) * (D / 64), I_FD = (D / 64) * (FF / 64);
constexpr int BG_DENSE = I_WOUT + 2 * I_FG + I_FD + I_WIN + I_WOUT, BG_TOTAL = BG_DENSE + NE * (2 * I_FG + I_FD);
__device__ __forceinline__ ConvJob bg_job(const Params& p, unsigned char* ws, int r) {
    ConvJob j;
    if (r < I_WOUT) { j.src = p.in[18]; j.dst = ws + WS_WOUT; j.f8 = 0; j.K = D; j.N = D; j.nt = r % (D / 64); j.kt = r / (D / 64); j.dst_row0 = j.nt * 64; return j; } r -= I_WOUT;
    if (r < 2 * I_FG) { const int u = r / I_FG; r -= u * I_FG; j.src = p.in[20 + u]; j.dst = ws + WS_FGU; j.f8 = 0; j.K = D; j.N = FF; j.nt = r % (FF / 64); j.kt = r / (FF / 64); j.dst_row0 = gu_row(j.nt * 64) + u * 128; return j; } r -= 2 * I_FG;
    if (r < I_FD) { j.src = p.in[22]; j.dst = ws + WS_FD; j.f8 = 0; j.K = FF; j.N = D; j.nt = r % (D / 64); j.kt = r / (D / 64); j.dst_row0 = j.nt * 64; return j; } r -= I_FD;
    if (r < I_WIN) { j.src = p.in[26]; j.dst = ws + WS_WIN + (size_t)NPP * D * 2; j.f8 = 0; j.K = D; j.N = NP1; j.nt = r % (NPP / 64); j.kt = r / (NPP / 64); j.dst_row0 = j.nt * 64; return j; } r -= I_WIN;
    if (r < I_WOUT) { j.src = p.in[41]; j.dst = ws + WS_WOUT + (size_t)D * D * 2; j.f8 = 0; j.K = D; j.N = D; j.nt = r % (D / 64); j.kt = r / (D / 64); j.dst_row0 = j.nt * 64; return j; } r -= I_WOUT;
    const int e = r / (2 * I_FG + I_FD); r -= e * (2 * I_FG + I_FD);
    if (r < 2 * I_FG) { const int u = r / I_FG; r -= u * I_FG; j.src = p.in[44 + u] + (size_t)e * D * FF; j.dst = ws + WS_EGU + (size_t)e * 2 * FF * D; j.f8 = 1; j.K = D; j.N = FF; j.nt = r % (FF / 64); j.kt = r / (FF / 64); j.dst_row0 = gu_row(j.nt * 64) + u * 128; return j; } r -= 2 * I_FG;
    j.src = p.in[46] + (size_t)e * FF * D; j.dst = ws + WS_ED + (size_t)e * D * FF; j.f8 = 1; j.K = FF; j.N = D; j.nt = r % (D / 64); j.kt = r / (D / 64); j.dst_row0 = j.nt * 64; return j;
}
__device__ __forceinline__ void p0_prologue(const Params& p, const Ctx& c_) {
    const Ctx c = fresh_ctx(c_);
    LAS unsigned* scr = (LAS unsigned*)(c.lds + c.wave * 16384);
    constexpr int TOTAL = I_MOD + I_WIN;
    unsigned char* ws = fresh_ws(p);
    f32x2 cv[32];
    for (int it = c.wg * NWAVE + c.wave; it < TOTAL; it += NGW) {
        int r = it;
        if (r < I_MOD) { p0_mod_item(p, c, r, (LAS float*)scr); continue; } r -= I_MOD;
        ConvJob j; j.src = p.in[5]; j.dst = ws + WS_WIN; j.f8 = 0; j.K = D; j.N = NP0; j.nt = r % (NPP / 64); j.kt = r / (NPP / 64); j.dst_row0 = j.nt * 64;
        conv_issue(j, cv, c.lane); conv_finish(j, cv, scr, c.lane);
    }
    for (int idx = (c.wg * NWAVE + c.wave) * 64 + c.lane; idx < 2 * 320 * C; idx += NGW * 64) {
        const int l = idx / (320 * C), rem = idx % (320 * C), k = rem / C, col = rem % C;
        const int pb = l ? 23 : 2;
        float v = 0.f;
        if (k < 64) v = p.in[pb + 6][(size_t)k * C + col]; else if (k < 128) v = p.in[pb + 8][(size_t)(k - 64) * C + col]; else if (k < 288) v = p.in[pb + 9][(size_t)(k - 128) * C + col];
        else if (l) v = p.in[34][(size_t)(k - 288) * C + col];
        ((bf16*)(ws + WS_LW))[((size_t)l * C + col) * 320 + k] = (bf16)(pk_bf16(v, 0.f) & 0xffffu);
    }
}

template <bool FROM_PARTIALS, bool ROUTE>
__device__ __forceinline__ void norm_mod_phase(const Params& p, const Ctx& c_, const float* x, const float* gain, int l, int shift_off, bf16* hout, const float* router) {
    const Ctx c = fresh_ctx(c_);
    LAS float* sh = (LAS float*)c.lds; LAS float* sc = sh + D;
    const int b = c.wg / 64;
    unsigned char* ws = fresh_ws(p);
    if (FROM_PARTIALS) {
        const float* mp = (const float*)(ws + WS_MODP); const float* mb = p.in[l ? 24 : 3];
        for (int i = c.tid; i < 2 * D; i += 512) { const int j = shift_off + i;
            float s = mb[j];
#pragma unroll
            for (int ks = 0; ks < KSPLIT; ++ks) s += mp[((size_t)(ks * 2 + l) * NB + b) * (6 * D) + j];
            sh[i] = s; }
        if (c.tid < 384) { const int idx = c.wg * 384 + c.tid; const int ll = idx / (NB * 6 * D), rem = idx % (NB * 6 * D), bb = rem / (6 * D), j = rem % (6 * D);
            float s = p.in[ll ? 24 : 3][j];
#pragma unroll
            for (int ks = 0; ks < KSPLIT; ++ks) s += mp[((size_t)(ks * 2 + ll) * NB + bb) * (6 * D) + j];
            ((float*)(ws + WS_MOD))[idx] = s; }
    } else {
        const float* md = (const float*)(ws + WS_MOD) + ((size_t)l * NB + b) * (6 * D) + shift_off;
        for (int i = c.tid; i < 2 * D; i += 512) sh[i] = md[i];
    }
    __syncthreads();
    for (int i = 0; i < 4; ++i) {
        const int m = c.wg * 32 + c.wave + 8 * i;
        const f32x4* xr = (const f32x4*)(x + (size_t)m * D) + c.lane;
        float ss = 0.f;
#pragma unroll
        for (int j = 0; j < 8; ++j) { const f32x4 t = xr[64 * j]; ss += (t[0] * t[0] + t[1] * t[1]) + (t[2] * t[2] + t[3] * t[3]); }
        ss = wave_sum(ss, c.lane);
        const float rn = 1.0f / sqrtf(ss * (1.0f / D) + 1e-6f);
        float lg[NE];
        if (ROUTE) {
#pragma unroll
            for (int e = 0; e < NE; ++e) lg[e] = 0.f; }
        u32x2* ho = (u32x2*)(hout + (size_t)m * D) + c.lane;
#pragma unroll 2
        for (int j = 0; j < 8; ++j) {
            const int d = 4 * (c.lane + 64 * j);
            const f32x4 g = *(const f32x4*)(gain + d); const f32x4 s1 = *(const LAS f32x4*)(sh + d); const f32x4 s2 = *(const LAS f32x4*)(sc + d);
            const f32x4 xv = xr[64 * j];
            f32x4 hv;
#pragma unroll
            for (int q = 0; q < 4; ++q) hv[q] = xv[q] * rn * g[q] * (1.0f + s2[q]) + s1[q];
            u32x2 w; w.x = pk_bf16(hv[0], hv[1]); w.y = pk_bf16(hv[2], hv[3]); ho[64 * j] = w;
            if (ROUTE) {
#pragma unroll
                for (int q = 0; q < 4; ++q) { const f32x4 r0 = *(const f32x4*)(router + (size_t)(d + q) * NE), r1 = *(const f32x4*)(router + (size_t)(d + q) * NE + 4);
                    lg[0] += hv[q] * r0[0]; lg[1] += hv[q] * r0[1]; lg[2] += hv[q] * r0[2]; lg[3] += hv[q] * r0[3];
                    lg[4] += hv[q] * r1[0]; lg[5] += hv[q] * r1[1]; lg[6] += hv[q] * r1[2]; lg[7] += hv[q] * r1[3]; } }
        }
        if (ROUTE) {
#pragma unroll
            for (int e = 0; e < NE; ++e) lg[e] = wave_sum(lg[e], c.lane);
            if (c.lane == 0) {
                int e1 = 0; float v1 = lg[0];
#pragma unroll
                for (int e = 1; e < NE; ++e) if (lg[e] > v1) { v1 = lg[e]; e1 = e; }
                int e2 = -1; float v2 = 0.f;
#pragma unroll
                for (int e = 0; e < NE; ++e) if (e != e1 && (e2 < 0 || lg[e] > v2)) { v2 = lg[e]; e2 = e; }
                const float p2 = __expf(v2 - v1); const float w1 = 1.0f / (1.0f + p2), w2 = p2 / (1.0f + p2);
                unsigned* cnt = (unsigned*)(ws + WS_CTL) + CW_CNT;
                const int pos1 = (int)__hip_atomic_fetch_add(cnt + 64 * e1, 1u, __ATOMIC_RELAXED, __HIP_MEMORY_SCOPE_AGENT);
                const int pos2 = (int)__hip_atomic_fetch_add(cnt + 64 * e2, 1u, __ATOMIC_RELAXED, __HIP_MEMORY_SCOPE_AGENT);
                int* te = (int*)(ws + WS_TOKE); int* tp = (int*)(ws + WS_TOKP); float* tw = (float*)(ws + WS_TOKW);
                te[2 * m] = e1; te[2 * m + 1] = e2; tp[2 * m] = pos1; tp[2 * m + 1] = pos2; tw[2 * m] = w1; tw[2 * m + 1] = w2;
            }
        }
    }
    __syncthreads();
}
__device__ __forceinline__ void moe_gather_phase(const Params& p, const Ctx& c_) {
    const Ctx c = fresh_ctx(c_);
    unsigned char* ws = fresh_ws(p);
    LAS int* tb = (LAS int*)(c.lds + LDSCTL_OFF + 64);
    const unsigned* cnt = (const unsigned*)(ws + WS_CTL) + CW_CNT;
    if (c.tid == 0) { int o = 0; for (int e = 0; e < NE; ++e) { tb[e] = o; o += ((int)__hip_atomic_load(cnt + 64 * e, __ATOMIC_RELAXED, __HIP_MEMORY_SCOPE_AGENT) + 255) >> 8; } tb[NE] = o; }
    __syncthreads();
    const int* te = (const int*)(ws + WS_TOKE); const int* tp = (const int*)(ws + WS_TOKP); int* ts = (int*)(ws + WS_TOKS);
    const bf16* h = (const bf16*)(ws + WS_H); unsigned char* am = ws + WS_REG + FX_AMOE;
    for (int i = 0; i < 4; ++i) {
        const int m = c.wg * 32 + c.wave + 8 * i;
        const u32x4* src = (const u32x4*)(h + (size_t)m * D) + c.lane;
        u32x2 v[4];
#pragma unroll
        for (int j = 0; j < 4; ++j) { const u32x4 w = src[64 * j];
            v[j].x = pg8::pk4_fp8_sat(bflo(w.x) * A8_SCALE, bfhi(w.x) * A8_SCALE, bflo(w.y) * A8_SCALE, bfhi(w.y) * A8_SCALE);
            v[j].y = pg8::pk4_fp8_sat(bflo(w.z) * A8_SCALE, bfhi(w.z) * A8_SCALE, bflo(w.w) * A8_SCALE, bfhi(w.w) * A8_SCALE); }
#pragma unroll
        for (int q = 0; q < 2; ++q) {
            const int slot = tb[te[2 * m + q]] * 256 + tp[2 * m + q];
            u32x2* dst = (u32x2*)(am + (size_t)slot * D) + c.lane;
#pragma unroll
            for (int j = 0; j < 4; ++j) dst[64 * j] = v[j];
            if (c.lane == 0) ts[2 * m + q] = slot;
        }
    }
    if (c.wg < NE) {
        const int e = c.wg; const int r0 = tb[e] * 256 + (int)__hip_atomic_load(cnt + 64 * e, __ATOMIC_RELAXED, __HIP_MEMORY_SCOPE_AGENT), r1 = tb[e + 1] * 256;
        const u32x4 z = {0u, 0u, 0u, 0u};
        for (int r = r0 + c.wave; r < r1; r += NWAVE) { u32x4* dst = (u32x4*)(am + (size_t)r * D) + c.lane; dst[0] = z; dst[64] = z; }
    }
}

template <int L>
__device__ __forceinline__ void prep_phase(const Params& p, const Ctx& c_) {
    const Ctx c = fresh_ctx(c_);
    constexpr int PB = L ? 23 : 2, Q = PB + 10 + (L ? 2 : 0);
    unsigned char* ws = fresh_ws(p);
    const bf16* proj = (const bf16*)(ws + WS_REG + MX_PROJ);
    const float* mu = p.in[PB + 4]; const float* w0 = p.in[PB + 5]; const float* a0 = p.in[PB + 7];
    const float* v0 = L ? p.in[PB + 10] : nullptr;
    const float* k_k = p.in[Q + 0]; const float* k_a = p.in[Q + 1]; const float* r_k = p.in[Q + 2];
    const bf16* lw = (const bf16*)(ws + WS_LW) + (size_t)L * C * 320;
    unsigned char* sin_ = ws + WS_REG + MX_SIN; bf16* sV = (bf16*)(ws + WS_REG + MX_SV); bf16* sG = (bf16*)(ws + WS_REG + MX_SG);
    bf16* vf = (bf16*)(ws + WS_VF); float* rkb = (float*)(ws + WS_RKB);
    constexpr int LZB = 656;
    LAS unsigned char* lz = c.lds;
    const int m0 = c.wg * 32;
#pragma unroll 1
    for (int rep_ = 0; rep_ < (REP_PHASE == 33 ? 2 : 1); ++rep_)
    { const int tk = c.tid >> 4, sub = c.tid & 15, m = m0 + tk; const bool has_prev = (m % T) != 0;
      const bf16* cur = proj + (size_t)m * NPP + 3072; const bf16* prv = cur - NPP;
#pragma unroll
      for (int i = 0; i < 10; ++i) { const int ic = 2 * (sub + 16 * i);
          unsigned o = 0u;
          if (L == 1 || ic < 288) {
              const unsigned cw = *(const unsigned*)(cur + ic); const unsigned pw = has_prev ? *(const unsigned*)(prv + ic) : 0u; const f32x2 mm = *(const f32x2*)(mu + 3072 + ic);
              float z0 = bflo(cw) + (bflo(pw) - bflo(cw)) * mm[0], z1 = bfhi(cw) + (bfhi(pw) - bfhi(cw)) * mm[1];
              if (ic < 64) { z0 = 1.0f - 2.0f * __builtin_amdgcn_rcpf(1.0f + __expf(2.0f * z0)); z1 = 1.0f - 2.0f * __builtin_amdgcn_rcpf(1.0f + __expf(2.0f * z1)); }
              else if (ic >= 128 && ic < 288) { z0 = sigmoid_f(z0); z1 = sigmoid_f(z1); }
              o = pk_bf16(z0, z1); }
          *(LAS unsigned*)(lz + tk * LZB + ic * 2) = o; } }
    __syncthreads();
    const int lane = c.lane, ti = lane & 15, g = lane >> 4;
    f32x4 acc[4];
#define LORA_LOAD2(wf_, KOFF, KS0, KS1) do { _Pragma("unroll") for (int ks = (KS0); ks < (KS1); ++ks) _Pragma("unroll") for (int ct = 0; ct < 4; ++ct) \
        wf_[ks][ct] = *(const bf16x8*)(lw + (size_t)(cbase + 16 * ct + ti) * 320 + (KOFF) + 32 * ks + 8 * g); } while (0)
#define LORA_LOAD(wf_, KOFF, KSTEPS) LORA_LOAD2(wf_, KOFF, 0, KSTEPS)
#define LORA_MMA(wf_, KOFF, KSTEPS) do { _Pragma("unroll") for (int ct = 0; ct < 4; ++ct) acc[ct] = (f32x4){0.f, 0.f, 0.f, 0.f}; \
        _Pragma("unroll") for (int ks = 0; ks < (KSTEPS); ++ks) { \
            const bf16x8 af = *(const LAS bf16x8*)(lz + (16 * tt + ti) * LZB + ((KOFF) + 32 * ks + 8 * g) * 2); \
            _Pragma("unroll") for (int ct = 0; ct < 4; ++ct) acc[ct] = __builtin_amdgcn_mfma_f32_16x16x32_bf16(wf_[ks][ct], af, acc[ct], 0, 0, 0); } } while (0)
#define SHIFT4(seg, cl, out) do { const u32x2 cw_ = *(const LAS u32x2*)(stg + (ti + 1) * 400 + (seg) * 128 + (cl) * 2), pw_ = *(const LAS u32x2*)(stg + ti * 400 + (seg) * 128 + (cl) * 2); \
        const f32x4 mu_ = *(const LAS f32x4*)(prm + (seg) * 64 + (cl)); \
        out[0] = bflo(cw_.x) + (bflo(pw_.x) - bflo(cw_.x)) * mu_[0]; out[1] = bfhi(cw_.x) + (bfhi(pw_.x) - bfhi(cw_.x)) * mu_[1]; \
        out[2] = bflo(cw_.y) + (bflo(pw_.y) - bflo(cw_.y)) * mu_[2]; out[3] = bfhi(cw_.y) + (bfhi(pw_.y) - bfhi(cw_.y)) * mu_[3]; } while (0)
    LAS unsigned char* stg = c.lds + 24576 + c.wave * 9216;
    LAS float* prm = (LAS float*)(stg + 6912);
#pragma unroll 1
    for (int it_ = 0; it_ < (REP_PHASE == 31 ? 8 : 4); ++it_) {
        const int it = it_ & 3, tt = c.wave & 1;
        const int head = 4 * (c.wave >> 1) + it, cbase = 64 * head;
        const int m = m0 + 16 * tt + ti;
        bf16x8 w1_[2][4], w2_[2][4], w3_[5][4], w4_[1][4];
        LORA_LOAD(w1_, 0, 2); LORA_LOAD(w2_, 64, 2);
        { const int mr0 = m0 + 16 * tt - 1; const bool first_zero = ((m0 + 16 * tt) % T) == 0;
          u32x4 sv_[7]; f32x4 pv_[3];
#pragma unroll
          for (int i = 0; i < 7; ++i) { int id = lane + 64 * i; id = id < 17 * 24 ? id : 17 * 24 - 1; const int row = id / 24, ch = id % 24, seg = ch >> 3, part = ch & 7;
              const int rr_ = (first_zero && row == 0) ? 1 : row;
              sv_[i] = *(const u32x4*)(proj + (size_t)(mr0 + rr_) * NPP + seg * 1024 + cbase + part * 8); }
#pragma unroll
          for (int i = 0; i < 3; ++i) { int id = lane + 64 * i; id = id < (L ? 144 : 128) ? id : 0; const int pi = id >> 4, part = id & 15;
              const float* src = pi < 3 ? mu + pi * 1024 : pi == 3 ? w0 : pi == 4 ? a0 : pi == 5 ? k_k : pi == 6 ? k_a : pi == 7 ? r_k : v0;
              pv_[i] = *(const f32x4*)(src + cbase + part * 4); }
          __builtin_amdgcn_sched_barrier(0);
#pragma unroll
          for (int i = 0; i < 7; ++i) { const int id = lane + 64 * i; if (id < 17 * 24) { const int row = id / 24, ch = id % 24, seg = ch >> 3, part = ch & 7;
              u32x4 v = sv_[i]; if (first_zero && row == 0) v = (u32x4){0u, 0u, 0u, 0u};
              *(LAS u32x4*)(stg + row * 400 + seg * 128 + part * 16) = v; } }
#pragma unroll
          for (int i = 0; i < 3; ++i) { const int id = lane + 64 * i; if (id < (L ? 144 : 128)) *(LAS f32x4*)(prm + (id >> 4) * 64 + (id & 15) * 4) = pv_[i]; }
          LDS_WAIT(); asm volatile("" ::: "memory"); }
        unsigned char* srec = sin_ + ((size_t)((m / T) * H + head) * T + (m % T)) * 768;
        LORA_MMA(w1_, 0, 2);
        LORA_LOAD2(w3_, 128, 0, 3); __builtin_amdgcn_sched_barrier(0);
#pragma unroll
        for (int ct = 0; ct < 4; ++ct) { const f32x4 b4 = *(const LAS f32x4*)(prm + 3 * 64 + 16 * ct + 4 * g); f32x4 o;
#pragma unroll
            for (int r = 0; r < 4; ++r) { const float nsw = -(acc[ct][r] + b4[r]); const float sp = nsw > 20.f ? nsw : __logf(1.0f + __expf(nsw)); o[r] = __expf(-__expf(-sp - 0.5f)); }
            *(f32x4*)(srec + (16 * ct + 4 * g) * 4) = o; }
        LORA_MMA(w2_, 64, 2);
        { f32x4 kkv[4], av[4]; float ss = 0.f, bs = 0.f;
#pragma unroll
          for (int ct = 0; ct < 4; ++ct) { const int cl = 16 * ct + 4 * g;
              const f32x4 ab = *(const LAS f32x4*)(prm + 4 * 64 + cl), kk4 = *(const LAS f32x4*)(prm + 5 * 64 + cl), ka4 = *(const LAS f32x4*)(prm + 6 * 64 + cl), rk4 = *(const LAS f32x4*)(prm + 7 * 64 + cl);
              float rr[4], kv[4]; SHIFT4(0, cl, rr); SHIFT4(1, cl, kv);
              f32x4 km, r4;
#pragma unroll
              for (int r = 0; r < 4; ++r) { const float a_ = sigmoid_f(acc[ct][r] + ab[r]); av[ct][r] = a_; const float n_ = kv[r] * kk4[r]; kkv[ct][r] = n_; ss += n_ * n_;
                  km[r] = kv[r] * (1.0f + (a_ - 1.0f) * ka4[r]); r4[r] = rr[r]; bs += rr[r] * km[r] * rk4[r]; }
              *(u32x2*)(srec + 512 + (16 * ct + 4 * g) * 2) = (u32x2){pk_bf16(km[0], km[1]), pk_bf16(km[2], km[3])}; *(u32x2*)(srec + 640 + (16 * ct + 4 * g) * 2) = (u32x2){pk_bf16(r4[0], r4[1]), pk_bf16(r4[2], r4[3])}; }
          ss += xor_lane(ss, lane, 16); ss += xor_lane(ss, lane, 32); bs += xor_lane(bs, lane, 16); bs += xor_lane(bs, lane, 32);
          const float inv = __builtin_amdgcn_rsqf(fmaxf(ss, 1e-24f));
#pragma unroll
          for (int ct = 0; ct < 4; ++ct) { const f32x4 n4 = kkv[ct] * inv, nb = n4 * av[ct]; *(u32x2*)(srec + 256 + (16 * ct + 4 * g) * 2) = (u32x2){pk_bf16(-n4[0], -n4[1]), pk_bf16(-n4[2], -n4[3])};
              *(u32x2*)(srec + 384 + (16 * ct + 4 * g) * 2) = (u32x2){pk_bf16(nb[0], nb[1]), pk_bf16(nb[2], nb[3])}; }
          if (g == 0) rkb[(size_t)m * H + head] = bs; }
        LORA_LOAD2(w3_, 128, 3, 5);
        LORA_MMA(w3_, 128, 5);
        if (L == 1) { LORA_LOAD(w4_, 288, 1); __builtin_amdgcn_sched_barrier(0); }
#pragma unroll
        for (int ct = 0; ct < 4; ++ct) *(u32x2*)(sG + (size_t)m * C + cbase + 16 * ct + 4 * g) = (u32x2){pk_bf16(acc[ct][0], acc[ct][1]), pk_bf16(acc[ct][2], acc[ct][3])};
        if (L == 1) LORA_MMA(w4_, 288, 1);
#pragma unroll
        for (int ct = 0; ct < 4; ++ct) { const int cl = 16 * ct + 4 * g, c4 = cbase + cl; float vv[4]; SHIFT4(2, cl, vv); f32x4 o = {vv[0], vv[1], vv[2], vv[3]};
            const size_t off = (size_t)m * C + c4;
            if (L == 0) *(u32x2*)(vf + off) = (u32x2){pk_bf16(o[0], o[1]), pk_bf16(o[2], o[3])};
            else { const u32x2 fw = *(const u32x2*)(vf + off); const f32x4 f = {bflo(fw.x), bfhi(fw.x), bflo(fw.y), bfhi(fw.y)}, vb = *(const LAS f32x4*)(prm + 8 * 64 + cl);
#pragma unroll
                for (int r = 0; r < 4; ++r) o[r] = o[r] + (f[r] - o[r]) * sigmoid_f(acc[ct][r] + vb[r]); }
            *(u32x2*)(sV + off) = (u32x2){pk_bf16(o[0], o[1]), pk_bf16(o[2], o[3])}; }
    }
#undef LORA_MMA
#undef LORA_LOAD
#undef LORA_LOAD2
#undef SHIFT4
    __syncthreads();
#pragma unroll 1
    for (int rep_ = 0; rep_ < (REP_PHASE == 32 ? 2 : 1); ++rep_)
    { constexpr int NR = L ? NR1 : NR0;
      const int n = c.wg % NBLK, hh = (c.wg / NBLK) % MH, b = c.wg / (NBLK * MH);
      LAS float* red = (LAS float*)c.lds;
      const int d4 = c.tid & 31, rg = c.tid >> 5;
      float s0 = 0.f, s1 = 0.f, s2 = 0.f, s3 = 0.f;
      for (int i = 0; i < 16; ++i) { const u32x2 w = *(const u32x2*)(proj + (size_t)(b * T + n * MBS + rg * 16 + i) * NPP + NR + 1024 + hh * MD + 4 * d4);
          s0 += bflo(w.x); s1 += bfhi(w.x); s2 += bflo(w.y); s3 += bfhi(w.y); }
      *(LAS f32x4*)(red + rg * 128 + 4 * d4) = (f32x4){s0, s1, s2, s3};
      __syncthreads();
      if (c.tid < 128) { float s = 0.f;
#pragma unroll
          for (int i = 0; i < 16; ++i) s += red[i * 128 + c.tid];
          ((float*)(ws + WS_KMEAN))[(size_t)c.wg * MD + c.tid] = s * (1.0f / MBS); }
      __syncthreads();
      bf16* vt = (bf16*)(ws + WS_REG + MX_VT);
#pragma unroll
      for (int i = 0; i < 8; ++i) { const int id = c.tid + 512 * i, key = id >> 4, part = id & 15;
          const u32x4 v = *(const u32x4*)(proj + (size_t)(b * T + n * MBS + key) * NPP + NR + 2048 + hh * MD + part * 8);
          *(LAS u32x4*)(c.lds + key * 256 + part * 16) = v; }
      __syncthreads();
#pragma unroll
      for (int i = 0; i < 8; ++i) { const int d = c.lane + 64 * (i & 1), kc = c.wave + 8 * (i >> 1);
          const LAS unsigned short* q = (const LAS unsigned short*)(c.lds + (8 * kc) * 256 + 2 * d);
          u32x4 o; o.x = q[0] | ((unsigned)q[128] << 16); o.y = q[256] | ((unsigned)q[384] << 16); o.z = q[512] | ((unsigned)q[640] << 16); o.w = q[768] | ((unsigned)q[896] << 16);
          *(u32x4*)(vt + ((size_t)(b * MH + hh) * MD + d) * T + n * MBS + 8 * kc) = o; }
      __syncthreads(); }
}

#define LDS_BARRIER() do { asm volatile("s_waitcnt lgkmcnt(0)" ::: "memory"); __builtin_amdgcn_s_barrier(); asm volatile("" ::: "memory"); } while (0)
template <int SCAN_ID>
__device__ __forceinline__ void scan_phase(const Params& p, const Ctx& c_) {
    const Ctx c = fresh_ctx(c_);
    unsigned char* ws = fresh_ws(p);
    const unsigned char* sin_ = ws + WS_REG + MX_SIN;
    const bf16* sV = (const bf16*)(ws + WS_REG + MX_SV); float* sY = (float*)(ws + WS_REG + MX_SY);
    const int xcd = c.wg & 7, j = c.wg >> 3, bh = xcd * 8 + (j >> 2), rq = j & 3, b = bh / H, h = bh % H;
    constexpr int TC = 32, NCH = T / TC, BUF = TC * 320;
    LAS float* inb = (LAS float*)c.lds;
    LAS float* vb = inb + 2 * BUF;
    LAS float* yb = vb + 2 * TC * 16;
    const unsigned char* src = sin_ + (size_t)bh * T * 768;
    constexpr int CHB = TC * 768;
#define SCAN_PARK(bufbase) do { _Pragma("unroll") for (int i = 0; i < 6; ++i) { const int pid = tl + 256 * i, t_ = pid / 48, pp = pid % 48; LAS float* d_ = (bufbase) + t_ * 320; \
        if (pp < 16) *(LAS f32x4*)(d_ + 64 + 4 * pp) = __builtin_bit_cast(f32x4, pre[i]); \
        else { const int qq = (pp - 16) >> 3, col = 8 * ((pp - 16) & 7), qd = qq == 0 ? 0 : qq + 1; const u32x4 w_ = pre[i]; \
            *(LAS f32x4*)(d_ + qd * 64 + col) = (f32x4){bflo(w_.x), bfhi(w_.x), bflo(w_.y), bfhi(w_.y)}; *(LAS f32x4*)(d_ + qd * 64 + col + 4) = (f32x4){bflo(w_.z), bfhi(w_.z), bflo(w_.w), bfhi(w_.w)}; } } } while (0)
    const size_t gv = (size_t)b * T * C + h * HN + 16 * rq;
    const bool loader = c.wave >= 4;
    const int tl = c.tid - 256;
    u32x4 pre[6]; float pv0 = 0.f, pv1 = 0.f;
    LAS unsigned* bscr = (LAS unsigned*)(c.lds + 90112 + (c.wave & 3) * 8448);
    const int lwid = c.wg * 4 + (c.wave & 3);
    if (loader) {
#pragma unroll
        for (int i = 0; i < 6; ++i) pre[i] = *(const u32x4*)(src + 16 * (tl + 256 * i));
        pv0 = bf2f(sV[gv + (size_t)(tl >> 4) * C + (tl & 15)]); pv1 = bf2f(sV[gv + (size_t)(16 + (tl >> 4)) * C + (tl & 15)]);
        SCAN_PARK(inb);
        vb[tl] = pv0; vb[256 + tl] = pv1;
#pragma unroll
        for (int i = 0; i < 6; ++i) pre[i] = *(const u32x4*)(src + (size_t)CHB + 16 * (tl + 256 * i));
        pv0 = bf2f(sV[gv + (size_t)(TC + (tl >> 4)) * C + (tl & 15)]); pv1 = bf2f(sV[gv + (size_t)(TC + 16 + (tl >> 4)) * C + (tl & 15)]);
    }
    const int rs = c.lane >> 4, cg = c.lane & 15;
    LDS_BARRIER();
    if (!loader) {
        f32x4 S = {0.f, 0.f, 0.f, 0.f};
        __builtin_amdgcn_s_setprio(3);
        for (int ch = 0; ch < NCH; ++ch) {
            const int cur = ch & 1;
            const LAS float* ib = inb + cur * BUF + 4 * cg; const LAS float* vv = vb + cur * TC * 16 + 4 * c.wave + rs;
            LAS float* yo = yb + cur * TC * 16 + 4 * c.wave + rs;
            f32x4 a4 = *(const LAS f32x4*)(ib), w4 = *(const LAS f32x4*)(ib + 64), b4 = *(const LAS f32x4*)(ib + 128), k4 = *(const LAS f32x4*)(ib + 192), r4 = *(const LAS f32x4*)(ib + 256);
            float vi = vv[0];
            float yacc = 0.f;
#pragma unroll
            for (int t = 0; t < TC; ++t) {
                f32x4 a4n = a4, w4n = w4, b4n = b4, k4n = k4, r4n = r4; float vin = vi;
                if (t + 1 < TC) { const LAS float* nb = ib + (t + 1) * 320;
                    a4n = *(const LAS f32x4*)(nb); w4n = *(const LAS f32x4*)(nb + 64); b4n = *(const LAS f32x4*)(nb + 128); k4n = *(const LAS f32x4*)(nb + 192); r4n = *(const LAS f32x4*)(nb + 256); vin = vv[(t + 1) * 16]; }
                float sa = (S[0] * a4[0] + S[1] * a4[1]) + (S[2] * a4[2] + S[3] * a4[3]);
                sa = row16_sum(sa);
                S = S * w4 + sa * b4 + vi * k4;
                float y = (S[0] * r4[0] + S[1] * r4[1]) + (S[2] * r4[2] + S[3] * r4[3]);
                y = row16_sum(y);
                yacc = (cg == (t & 15)) ? y : yacc;
                if ((t & 15) == 15) yo[((t & 16) + cg) * 16] = yacc;
                a4 = a4n; w4 = w4n; b4 = b4n; k4 = k4n; r4 = r4n; vi = vin;
            }
            LDS_BARRIER();
        }
        __builtin_amdgcn_s_setprio(0);
    } else {
        f32x2 cvA[32], cvB[32]; ConvJob bjA, bjB; bool pendA = false, pendB = false;
        constexpr int BG_HALF = (BG_TOTAL + 1) / 2;
#define SCAN_LOADER_ITER(ch_, cvX, bjX, pendX) do { const int cur = (ch_) & 1; \
            if ((ch_) + 1 < NCH) { SCAN_PARK(inb + (cur ^ 1) * BUF); vb[(cur ^ 1) * TC * 16 + tl] = pv0; vb[(cur ^ 1) * TC * 16 + 256 + tl] = pv1; } \
            if ((ch_) + 2 < NCH) { const unsigned char* s2 = src + (size_t)((ch_) + 2) * CHB; \
                _Pragma("unroll") for (int i = 0; i < 6; ++i) pre[i] = *(const u32x4*)(s2 + 16 * (tl + 256 * i)); \
                const size_t o = gv + (size_t)(((ch_) + 2) * TC) * C; \
                pv0 = bf2f(sV[o + (size_t)(tl >> 4) * C + (tl & 15)]); pv1 = bf2f(sV[o + (size_t)(16 + (tl >> 4)) * C + (tl & 15)]); } \
            if ((ch_) > 0) { const size_t o = gv + (size_t)(((ch_) - 1) * TC) * C; const LAS float* ys = yb + (cur ^ 1) * TC * 16; \
                sY[o + (size_t)(tl >> 4) * C + (tl & 15)] = ys[tl]; sY[o + (size_t)(16 + (tl >> 4)) * C + (tl & 15)] = ys[256 + tl]; } \
            if (pendX) { conv_finish(bjX, cvX, bscr, c.lane); pendX = false; } \
            { constexpr int PER = (BG_HALF + NCH - 1) / NCH;                          \
              const int r_ = (lwid - (ch_) * PER) & (NWG * 4 - 1); const int bi = SCAN_ID * BG_HALF + (ch_) * PER + r_; \
              if (r_ < PER && bi < (SCAN_ID ? BG_TOTAL : BG_HALF)) { bjX = bg_job(p, ws, bi); conv_issue(bjX, cvX, c.lane); pendX = true; } } \
            LDS_BARRIER(); } while (0)
        for (int ch = 0; ch < NCH; ch += 2) { SCAN_LOADER_ITER(ch, cvA, bjA, pendA); SCAN_LOADER_ITER(ch + 1, cvB, bjB, pendB); }
#undef SCAN_LOADER_ITER
        { const size_t o = gv + (size_t)((NCH - 1) * TC) * C; const LAS float* ys = yb + ((NCH - 1) & 1) * TC * 16;
          sY[o + (size_t)(tl >> 4) * C + (tl & 15)] = ys[tl]; sY[o + (size_t)(16 + (tl >> 4)) * C + (tl & 15)] = ys[256 + tl];
          if (pendA) conv_finish(bjA, cvA, bscr, c.lane); if (pendB) conv_finish(bjB, cvB, bscr, c.lane); }
    }
    __syncthreads();
#undef SCAN_PARK
}


template <int L>
__device__ __forceinline__ void mix_post_phase(const Params& p, const Ctx& c_) {
    const Ctx c = fresh_ctx(c_);
    constexpr int PB = L ? 23 : 2, Q = PB + 10 + (L ? 2 : 0);
    unsigned char* ws = fresh_ws(p);
    const float* ln_w = p.in[Q + 3]; const float* ln_b = p.in[Q + 4];
    const float* sY = (const float*)(ws + WS_REG + MX_SY); const bf16* sV = (const bf16*)(ws + WS_REG + MX_SV); const bf16* sG = (const bf16*)(ws + WS_REG + MX_SG);
    const float* rkb = (const float*)(ws + WS_RKB); bf16* cat = (bf16*)(ws + WS_CAT);
    const int gw = c.wg * NWAVE + c.wave, hl = c.lane >> 4;
    for (int it = gw; it < 4 * M; it += NGW) {
        const int m = it >> 2, ch = (it & 3) * 256 + 4 * c.lane, h = ch >> 6;
        const size_t o = (size_t)m * C + ch;
        const f32x4 y = *(const f32x4*)(sY + o);
        const u32x2 vw = *(const u32x2*)(sV + o), gw_ = *(const u32x2*)(sG + o);
        const f32x4 lw4 = *(const f32x4*)(ln_w + ch), lb4 = *(const f32x4*)(ln_b + ch);
        const float bon = rkb[(size_t)m * H + h];
        const float mean = row16_sum((y[0] + y[1]) + (y[2] + y[3])) * (1.0f / 64.0f);
        const f32x4 dy = y - mean;
        const float var = row16_sum((dy[0] * dy[0] + dy[1] * dy[1]) + (dy[2] * dy[2] + dy[3] * dy[3])) * (1.0f / 64.0f);
        const float rs = 1.0f / sqrtf(var + 64e-5f);
        const f32x4 v4 = {bflo(vw.x), bfhi(vw.x), bflo(vw.y), bfhi(vw.y)}, g4 = {bflo(gw_.x), bfhi(gw_.x), bflo(gw_.y), bfhi(gw_.y)};
        const f32x4 ov = (dy * rs * lw4 + lb4 + bon * v4) * g4;
        *(u32x2*)(cat + (size_t)m * D + ch) = (u32x2){pk_bf16(ov[0], ov[1]), pk_bf16(ov[2], ov[3])};
    }
    (void)hl;
    __syncthreads();
}

template <int L>
__device__ __forceinline__ void moba_phase(const Params& p, const Ctx& c_) {
    const Ctx c = fresh_ctx(c_);
    constexpr int PB = L ? 23 : 2, Q = PB + 10 + (L ? 2 : 0), NR = L ? NR1 : NR0;
    unsigned char* ws = fresh_ws(p);
    const bf16* proj = (const bf16*)(ws + WS_REG + MX_PROJ); const bf16* vt = (const bf16*)(ws + WS_REG + MX_VT);
    const float* kmean = (const float*)(ws + WS_KMEAN); const float* gain = p.in[Q + 5]; bf16* cat = (bf16*)(ws + WS_CAT);
    const int xj_ = c.wg >> 3, bh_ = (c.wg & 7) * 4 + (xj_ >> 3), un_ = xj_ & 7;
    const int hf0 = un_ & 1, pr = un_ >> 1, h = bh_ & 7, b = bh_ >> 3;
    const int lane = c.lane, qi = lane & 15, g = lane >> 4;
    const float slope = exp2f(-(float)(h + 1)), scale = 0.08838834764831845f;
    constexpr int KROW = 272, VROW = 272, KBUF = 64 * KROW, VBUF = 128 * VROW;
    LAS unsigned char* KB = c.lds; LAS unsigned char* VB = c.lds + 2 * KBUF;
    const bf16* kbase = proj + (size_t)(b * T) * NPP + NR + 1024 + h * MD;
    const bf16* vbase = vt + (size_t)(b * MH + h) * MD * T;
    u32x4 stg[4];
#define MOBA_LOAD(key0) do { _Pragma("unroll") for (int i_ = 0; i_ < 2; ++i_) { const int id_ = c.tid + 512 * i_; \
        stg[i_] = *(const u32x4*)(kbase + (size_t)((key0) + (id_ >> 4)) * NPP + (id_ & 15) * 8); \
        stg[2 + i_] = *(const u32x4*)(vbase + (size_t)(id_ >> 3) * T + (key0) + (id_ & 7) * 8); } } while (0)
#define MOBA_STORE(buf) do { _Pragma("unroll") for (int i_ = 0; i_ < 2; ++i_) { const int id_ = c.tid + 512 * i_; \
        *(LAS u32x4*)(KB + (buf) * KBUF + (id_ >> 4) * KROW + (id_ & 15) * 16) = stg[i_]; \
        *(LAS u32x4*)(VB + (buf) * VBUF + (id_ >> 3) * VROW + (id_ & 7) * 16) = stg[2 + i_]; } } while (0)
    constexpr float LOG2E = 1.4426950408889634f;
    const float slope2 = slope * LOG2E, qscale = scale * LOG2E;
    for (int uu = 0; uu < 2; ++uu) {
        const int own = uu ? 7 - pr : pr, hf = uu ? 1 - hf0 : hf0;
        const int tq = own * MBS + hf * 128 + 16 * c.wave + qi;
        const int tq_lo = own * MBS + hf * 128 + 16 * c.wave;
        const size_t mrow = (size_t)(b * T + tq);
        bf16x8 qf[4];
#pragma unroll
        for (int ds = 0; ds < 4; ++ds) { const u32x4 qw = *(const u32x4*)(proj + mrow * NPP + NR + h * MD + 32 * ds + 8 * g);
            u32x4 o; o.x = pk_bf16(bflo(qw.x) * qscale, bfhi(qw.x) * qscale); o.y = pk_bf16(bflo(qw.y) * qscale, bfhi(qw.y) * qscale);
            o.z = pk_bf16(bflo(qw.z) * qscale, bfhi(qw.z) * qscale); o.w = pk_bf16(bflo(qw.w) * qscale, bfhi(qw.w) * qscale); qf[ds] = __builtin_bit_cast(bf16x8, o); }
        unsigned selmask = 0u;
        {
            float gt[8];
#pragma unroll
            for (int n = 0; n < 8; ++n) {
                float s = 0.f;
                if (n < own) {
                    const float* km = kmean + ((size_t)(b * MH + h) * NBLK + n) * MD + 8 * g;
#pragma unroll
                    for (int ds = 0; ds < 4; ++ds) { const f32x4 k0 = *(const f32x4*)(km + 32 * ds), k1 = *(const f32x4*)(km + 32 * ds + 4);
                        const u32x4 qw = __builtin_bit_cast(u32x4, qf[ds]);
                        s += bflo(qw.x) * k0[0] + bfhi(qw.x) * k0[1] + bflo(qw.y) * k0[2] + bfhi(qw.y) * k0[3] + bflo(qw.z) * k1[0] + bfhi(qw.z) * k1[1] + bflo(qw.w) * k1[2] + bfhi(qw.w) * k1[3]; }
                    s += xor_lane(s, lane, 16); s += xor_lane(s, lane, 32);
                }
                gt[n] = s;
            }
            const int nsel = own < 3 ? own : 3;
#pragma unroll
            for (int s = 0; s < 3; ++s) if (s < nsel) {
                int best = -1; float bv = 0.f;
#pragma unroll
                for (int n = 0; n < 8; ++n) { const bool cand = (n < own) && !((selmask >> n) & 1u); if (cand && (best < 0 || gt[n] > bv)) { best = n; bv = gt[n]; } }
                selmask |= 1u << best;
            }
        }
        const int nsteps = own * 4 + (hf ? 4 : 2);
        float m_run = -1e30f, l_run = 0.f;
        f32x4 acc[8];
#pragma unroll
        for (int dt = 0; dt < 8; ++dt) acc[dt] = (f32x4){0.f, 0.f, 0.f, 0.f};
#define MOBA_LDSBAR() do { asm volatile("s_waitcnt lgkmcnt(0)" ::: "memory"); __builtin_amdgcn_s_barrier(); asm volatile("" ::: "memory"); } while (0)
#define MOBA_LOADR(dst, key0) do { _Pragma("unroll") for (int i_ = 0; i_ < 2; ++i_) { const int id_ = c.tid + 512 * i_; \
        dst[i_] = *(const u32x4*)(kbase + (size_t)((key0) + (id_ >> 4)) * NPP + (id_ & 15) * 8); \
        dst[2 + i_] = *(const u32x4*)(vbase + (size_t)(id_ >> 3) * T + (key0) + (id_ & 7) * 8); } } while (0)
#define MOBA_STORER(src, buf) do { _Pragma("unroll") for (int i_ = 0; i_ < 2; ++i_) { const int id_ = c.tid + 512 * i_; \
        *(LAS u32x4*)(KB + (buf) * KBUF + (id_ >> 4) * KROW + (id_ & 15) * 16) = src[i_]; \
          \
        { const int part_ = id_ & 7, grp_ = part_ >> 2, q_ = part_ & 3, t_ = q_ >> 1, g0_ = 2 * (q_ & 1); LAS unsigned char* vd_ = VB + (buf) * VBUF + (id_ >> 3) * VROW + grp_ * 64 + t_ * 8; \
          *(LAS u32x2*)(vd_ + g0_ * 16) = (u32x2){src[2 + i_].x, src[2 + i_].y}; *(LAS u32x2*)(vd_ + (g0_ + 1) * 16) = (u32x2){src[2 + i_].z, src[2 + i_].w}; } } } while (0)
#define MOBA_STEP(step_, buf_) do { const int step = (step_), buf = (buf_); const int kb = step >> 2, key0 = step * 64; (void)buf; \
            const bool mine = (kb == own) || ((selmask >> kb) & 1u); \
            if (__any(mine)) { \
                const LAS unsigned char* kt_ = KB + buf * KBUF + qi * KROW + 16 * g; \
                f32x4 st[4]; \
_Pragma("unroll") \
                for (int kt = 0; kt < 4; ++kt) { st[kt] = (f32x4){0.f, 0.f, 0.f, 0.f}; \
_Pragma("unroll") \
                    for (int ds = 0; ds < 4; ++ds) { const bf16x8 kf = *(const LAS bf16x8*)(kt_ + kt * 16 * KROW + ds * 64); st[kt] = __builtin_amdgcn_mfma_f32_16x16x32_bf16(kf, qf[ds], st[kt], 0, 0, 0); } } \
                const float base = slope2 * (float)(key0 + 4 * g - tq); \
                float mx = -1e30f; \
                if (kb == own && key0 + 63 > tq_lo) {                                \
_Pragma("unroll") \
                    for (int kt = 0; kt < 4; ++kt) \
_Pragma("unroll") \
                        for (int r = 0; r < 4; ++r) { const int kp = key0 + 16 * kt + 4 * g + r; \
                            const float sv = st[kt][r] + (base + slope2 * (float)(16 * kt + r)); \
                            st[kt][r] = (kp <= tq) ? sv : -1e30f; mx = fmaxf(mx, st[kt][r]); } \
                } else {                                                              \
_Pragma("unroll") \
                    for (int kt = 0; kt < 4; ++kt) \
_Pragma("unroll") \
                        for (int r = 0; r < 4; ++r) { st[kt][r] += base + slope2 * (float)(16 * kt + r); mx = fmaxf(mx, st[kt][r]); } \
                } \
                mx = mine ? mx : -1e30f;                                              \
                mx = fmaxf(mx, xor_lane(mx, lane, 16)); mx = fmaxf(mx, xor_lane(mx, lane, 32)); \
                const float m_new = fmaxf(m_run, mx); \
                const float alpha = __builtin_amdgcn_exp2f(m_run - m_new); \
                m_run = m_new; \
                const float m_eff = mine ? m_new : 1e30f; \
                float ps = 0.f; \
_Pragma("unroll") \
                for (int kt = 0; kt < 4; ++kt) \
_Pragma("unroll") \
                    for (int r = 0; r < 4; ++r) { const float pv = __builtin_amdgcn_exp2f(st[kt][r] - m_eff); st[kt][r] = pv; ps += pv; } \
                l_run = l_run * alpha + ps; \
_Pragma("unroll") \
                for (int dt = 0; dt < 8; ++dt) acc[dt] = acc[dt] * alpha; \
                const LAS unsigned char* vt_ = VB + buf * VBUF + qi * VROW + 16 * g; \
_Pragma("unroll") \
                for (int kk = 0; kk < 2; ++kk) { \
                    u32x4 pw; pw.x = pk_bf16(st[2 * kk][0], st[2 * kk][1]); pw.y = pk_bf16(st[2 * kk][2], st[2 * kk][3]); pw.z = pk_bf16(st[2 * kk + 1][0], st[2 * kk + 1][1]); pw.w = pk_bf16(st[2 * kk + 1][2], st[2 * kk + 1][3]); \
                    const bf16x8 pf = __builtin_bit_cast(bf16x8, pw); \
_Pragma("unroll") \
                    for (int dt = 0; dt < 8; ++dt) { const bf16x8 vw = *(const LAS bf16x8*)(vt_ + dt * 16 * VROW + kk * 64); \
                        acc[dt] = __builtin_amdgcn_mfma_f32_16x16x32_bf16(vw, pf, acc[dt], 0, 0, 0); } \
                } \
            } \
            } while (0)
        u32x4 sa_[4], sb_[4];
        __syncthreads();
        MOBA_LOADR(sa_, 0); MOBA_STORER(sa_, 0);
        MOBA_LOADR(sb_, 64);
        if (nsteps > 2) MOBA_LOADR(sa_, 128);
        MOBA_LDSBAR();
        for (int st2 = 0; st2 < nsteps; st2 += 2) {
            MOBA_STEP(st2, 0);
            MOBA_STORER(sb_, 1);
            if (st2 + 3 < nsteps) MOBA_LOADR(sb_, (st2 + 3) * 64);
            MOBA_LDSBAR();
            MOBA_STEP(st2 + 1, 1);
            if (st2 + 2 < nsteps) MOBA_STORER(sa_, 0);
            if (st2 + 4 < nsteps) MOBA_LOADR(sa_, (st2 + 4) * 64);
            MOBA_LDSBAR();
        }
#undef MOBA_STEP
#undef MOBA_LOADR
#undef MOBA_STORER
#undef MOBA_LDSBAR
        l_run += xor_lane(l_run, lane, 16); l_run += xor_lane(l_run, lane, 32);
        const float inv = 1.0f / l_run;
        float ss = 0.f;
#pragma unroll
        for (int dt = 0; dt < 8; ++dt) { acc[dt] = acc[dt] * inv; ss += (acc[dt][0] * acc[dt][0] + acc[dt][1] * acc[dt][1]) + (acc[dt][2] * acc[dt][2] + acc[dt][3] * acc[dt][3]); }
        ss += xor_lane(ss, lane, 16); ss += xor_lane(ss, lane, 32);
        const float rn = 1.0f / sqrtf(ss * (1.0f / MD) + 1e-6f);
        bf16* op = cat + mrow * D + C + h * MD + 4 * g;
#pragma unroll
        for (int dt = 0; dt < 8; ++dt) { const f32x4 gg = *(const f32x4*)(gain + h * MD + 16 * dt + 4 * g);
            u32x2 w; w.x = pk_bf16(acc[dt][0] * rn * gg[0], acc[dt][1] * rn * gg[1]); w.y = pk_bf16(acc[dt][2] * rn * gg[2], acc[dt][3] * rn * gg[3]);
            *(u32x2*)(op + 16 * dt) = w; }
    }
#undef MOBA_LOAD
#undef MOBA_STORE
    __syncthreads();
}

__device__ __forceinline__ void final_phase(const Params& p, const Ctx& c_) {
    const Ctx c = fresh_ctx(c_);
    unsigned char* ws = fresh_ws(p);
    const float* x1 = (const float*)(ws + WS_X1); const bf16* os = (const bf16*)(ws + WS_REG + FX_OSLOT);
    const int* ts = (const int*)(ws + WS_TOKS); const float* tw = (const float*)(ws + WS_TOKW); const float* gain = p.in[47];
    for (int i = 0; i < 4; ++i) {
        const int m = c.wg * 32 + c.wave + 8 * i, b = m / T;
        const float* gt = (const float*)(ws + WS_MOD) + ((size_t)1 * NB + b) * (6 * D) + 5 * D;
        const int s1 = ts[2 * m], s2 = ts[2 * m + 1]; const float w1 = tw[2 * m], w2 = tw[2 * m + 1];
        const f32x4* xr = (const f32x4*)(x1 + (size_t)m * D) + c.lane; const u32x2* o1 = (const u32x2*)(os + (size_t)s1 * D) + c.lane; const u32x2* o2 = (const u32x2*)(os + (size_t)s2 * D) + c.lane;
        const f32x4* gp = (const f32x4*)gt + c.lane;
        f32x4 v[8]; float ss = 0.f;
#pragma unroll
        for (int j = 0; j < 8; ++j) { const u32x2 a = o1[64 * j], bq = o2[64 * j];
            const f32x4 e1 = {bflo(a.x), bfhi(a.x), bflo(a.y), bfhi(a.y)}, e2 = {bflo(bq.x), bfhi(bq.x), bflo(bq.y), bfhi(bq.y)};
            v[j] = xr[64 * j] + gp[64 * j] * (w1 * e1 + w2 * e2); ss += (v[j][0] * v[j][0] + v[j][1] * v[j][1]) + (v[j][2] * v[j][2] + v[j][3] * v[j][3]); }
        ss = wave_sum(ss, c.lane);
        const float rn = 1.0f / sqrtf(ss * (1.0f / D) + 1e-6f);
        f32x4* op = (f32x4*)(p.out + (size_t)m * D) + c.lane;
#pragma unroll
        for (int j = 0; j < 8; ++j) op[64 * j] = v[j] * rn * ((const f32x4*)gain)[c.lane + 64 * j];
    }
}

template <int L>
__device__ __forceinline__ void layer_phases(const Params& p, const Ctx& c, const XcdBarrier& bar, const float* xin) {
    constexpr int PB = L ? 23 : 2, Q = PB + 10 + (L ? 2 : 0);
    unsigned char* ws = fresh_ws(p);
    bf16* hb = (bf16*)(ws + WS_H);
    const float* modl = (const float*)(ws + WS_MOD) + (size_t)L * NB * 6 * D;
    PH(1, norm_mod_phase<L == 0, false>(p, c, xin, p.in[PB + 2], L, 0, hb, nullptr));
    xcd_barrier(bar);
    { pg8::Gemm g{hb, (const bf16*)(ws + WS_WIN) + (size_t)L * NPP * D, M, NPP, D}; pg8::StaticOrder S; S.init(M, NPP, NWG, c.wg);
      pg8::EpiStoreBf16 E{(bf16*)(ws + WS_REG + MX_PROJ), NPP};
      PH(2, pg8::gemm_phase<pg8::EpiStoreBf16, pg8::StaticOrder, true, true>(c.lds, g, S, E, c.wave)); }
    xcd_barrier(bar);
    PH(3, prep_phase<L>(p, c));
    xcd_barrier(bar);
    PH(4, scan_phase<L>(p, c));
    xcd_barrier(bar);
    PH(5, mix_post_phase<L>(p, c));
    PH(11, moba_phase<L>(p, c));
    xcd_barrier(bar);
    { pg8::Gemm g{(const bf16*)(ws + WS_CAT), (const bf16*)(ws + WS_WOUT) + (size_t)L * D * D, M, D, D}; pg8::StaticOrder S; S.init(M, D, NWG, c.wg);
      pg8::EpiResid E{(float*)(ws + WS_X1), xin, modl + 2 * D, D, 6 * D, T / 256};
      PH(6, pg8::gemm_phase<pg8::EpiResid, pg8::StaticOrder, true, true>(c.lds, g, S, E, c.wave)); }
    xcd_barrier(bar);
    norm_mod_phase<false, L == 1>(p, c, (const float*)(ws + WS_X1), p.in[Q + 7], L, 3 * D, hb, L ? p.in[43] : nullptr);
    xcd_barrier(bar);
    if (L == 0) {
        { pg8::Gemm g{hb, (const bf16*)(ws + WS_FGU), M, 2 * FF, D}; pg8::StaticOrder S; S.init(M, 2 * FF, NWG, c.wg);
          pg8::EpiSwiglu E{(bf16*)(ws + WS_REG + FX_ACT), FF, NFT};
          PH(8, pg8::gemm_phase<pg8::EpiSwiglu, pg8::StaticOrder, true, true>(c.lds, g, S, E, c.wave)); }
        xcd_barrier(bar);
        { pg8::Gemm g{(const bf16*)(ws + WS_REG + FX_ACT), (const bf16*)(ws + WS_FD), M, D, FF}; pg8::StaticOrder S; S.init(M, D, NWG, c.wg);
          pg8::EpiResid E{(float*)(ws + WS_X2), (const float*)(ws + WS_X1), modl + 5 * D, D, 6 * D, T / 256};
          PH(9, pg8::gemm_phase<pg8::EpiResid, pg8::StaticOrder, true, true>(c.lds, g, S, E, c.wave)); }
        xcd_barrier(bar);
    } else {
        PH(7, moe_gather_phase(p, c));
        xcd_barrier(bar);
        const LAS int* tb = (const LAS int*)(c.lds + LDSCTL_OFF + 64);
        { pg8::Gemm g{(const bf16*)(ws + WS_REG + FX_AMOE), (const bf16*)(ws + WS_EGU), SLOTS, NE * 2 * FF, D / 2}; pg8::MoeOrder S{tb, NFT, NWG, c.wg};
          pg8::EpiSwigluF8 E{ws + WS_REG + FX_ACT, FF, NFT, 1.0f / (A8_SCALE * W8_SCALE), H8_SCALE};
          PH(8, pg8::gemm_phase<pg8::EpiSwigluF8, pg8::MoeOrder, true, true, true>(c.lds, g, S, E, c.wave)); }
        xcd_barrier(bar);
        { pg8::Gemm g{(const bf16*)(ws + WS_REG + FX_ACT), (const bf16*)(ws + WS_ED), SLOTS, NE * D, FF / 2}; pg8::MoeOrder S{tb, D / 256, NWG, c.wg};
          pg8::EpiStoreBf16S E{(bf16*)(ws + WS_REG + FX_OSLOT), D, D / 256, 1.0f / (H8_SCALE * W8_SCALE)};
          PH(9, pg8::gemm_phase<pg8::EpiStoreBf16S, pg8::MoeOrder, true, true, true>(c.lds, g, S, E, c.wave)); }
        xcd_barrier(bar);
        PH(10, final_phase(p, c));
    }
}

__global__ void __launch_bounds__(512, 2) fwd_kernel(Params p) {
    extern __shared__ __attribute__((aligned(16))) unsigned char lds_raw[];
    Ctx c; c.lds = (LAS unsigned char*)lds_raw; c.wave = __builtin_amdgcn_readfirstlane((int)threadIdx.x >> 6); asm volatile("v_mbcnt_lo_u32_b32 %0, -1, 0\n\tv_mbcnt_hi_u32_b32 %0, -1, %0" : "=v"(c.lane)); c.tid = c.wave * 64 + c.lane; c.wg = blockIdx.x;
    for (int u = c.tid; u < (LDS_BYTES - LDSCTL_OFF) / 4; u += 512) ((LAS unsigned*)(c.lds + LDSCTL_OFF))[u] = 0u;
    __syncthreads();
    const XcdBarrier bar = xcd_barrier_post((unsigned*)(p.ws + WS_CTL) + CW_BAR, (volatile LAS unsigned*)(c.lds + LDSCTL_OFF));
    PH(0, p0_prologue(p, c));
    xcd_barrier(bar);
    layer_phases<0>(p, c, bar, p.in[0]);
    layer_phases<1>(p, c, bar, (const float*)(p.ws + WS_X2));
}
}

extern "C" void kernel_launch(void* const* d_in, const int* in_sizes, int n_in, void* d_out, int out_size, void* d_ws, size_t ws_size, hipStream_t stream) {
    if (n_in != 48 || out_size != M * D || ws_size < WS_END) { fprintf(stderr, "kernel_launch: unexpected problem (n_in %d out %d ws %zu need %zu)\n", n_in, out_size, ws_size, (size_t)WS_END); return; }
    static int ready = 0;
    if (!ready) {
        if (hipFuncSetAttribute((const void*)fwd_kernel, hipFuncAttributeMaxDynamicSharedMemorySize, LDS_BYTES) != hipSuccess) { fprintf(stderr, "kernel_launch: hipFuncSetAttribute failed\n"); return; }
        int per_cu = 0, dev = 0, cus = 0;
        (void)hipGetDevice(&dev); (void)hipDeviceGetAttribute(&cus, hipDeviceAttributeMultiprocessorCount, dev);
        if (hipOccupancyMaxActiveBlocksPerMultiprocessor(&per_cu, (const void*)fwd_kernel, 512, LDS_BYTES) != hipSuccess || per_cu < 1 || cus < NWG) { fprintf(stderr, "kernel_launch: grid of %d workgroups is not resident (per_cu %d, cus %d)\n", NWG, per_cu, cus); return; }
        ready = 1;
    }
    (void)hipMemsetAsync((char*)d_ws + WS_CTL, 0, CTL_BYTES, stream);
    Params p; memset(&p, 0, sizeof(p));
    for (int i = 0; i < 48; ++i) p.in[i] = (const float*)d_in[i];
    p.out = (float*)d_out; p.ws = (unsigned char*)d_ws;
    hipLaunchKernelGGL(fwd_kernel, dim3(NWG), dim3(512), LDS_BYTES, stream, p);
}
```
